# Optimizing an MI355X kernel written in HIP

```python
import jax, jax.numpy as jnp
from jax import lax
import numpy as np

D_MODEL = 1024
BATCH = 4
SEQ = 4096
DEPTH = 4

MEM_LEN = 256
HEAD_DIM = 64
N_SB_HEADS = 8
N_FOX_HEADS = 8
N_MEM_HEADS = 4
MEM_HEAD_DIM = 128
SB_W = N_SB_HEADS * HEAD_DIM
FOX_W = N_FOX_HEADS * HEAD_DIM
MEM_W = N_MEM_HEADS * MEM_HEAD_DIM
N_BRANCH = 3
IN_W = 3 * SB_W + 3 * FOX_W + N_FOX_HEADS + MEM_W
D_FF = ((8 * D_MODEL // 3 + 127) // 128) * 128
Q_BLOCK = 128
RMS_EPS = 1e-6

kernel_name = 'hybrid_sb_fox_mem_macaron'


def _rmsnorm(t, g):
    t32 = t.astype(jnp.float32)
    t32 = t32 * lax.rsqrt(jnp.mean(t32 * t32, axis=-1, keepdims=True) + RMS_EPS)
    return t32.astype(t.dtype) * g


def _swiglu(t, w_gate, w_up, w_down):
    return (jax.nn.silu(t @ w_gate) * (t @ w_up)) @ w_down


def _split_heads(t, n_heads):
    b, s, _ = t.shape
    return t.reshape(b, s, n_heads, -1).transpose(0, 2, 1, 3)


def _merge_heads(t):
    b, h, s, d = t.shape
    return t.transpose(0, 2, 1, 3).reshape(b, s, h * d)


def _query_blocks(t):
    b, h, s = t.shape[:3]
    t = t.reshape((b, h, s // Q_BLOCK, Q_BLOCK) + t.shape[3:])
    return jnp.moveaxis(t, 2, 0)


def _unblock(o):
    nb, b, h, blk, d = o.shape
    return jnp.moveaxis(o, 0, 2).reshape(b, h, nb * blk, d)


def _stick_breaking_attention(q, k, v):
    b, h, s_len, d = q.shape
    scale = d ** -0.5
    key_pos = jnp.arange(s_len)

    def block(args):
        qb, i = args
        z = jnp.einsum('bhqd,bhkd->bhqk', qb, k).astype(jnp.float32) * scale
        q_pos = i * Q_BLOCK + jnp.arange(Q_BLOCK)
        mask = key_pos[None, :] < q_pos[:, None]
        log_beta = jax.nn.log_sigmoid(z)
        log_not = jnp.where(mask, log_beta - z, 0.0)
        log_between = lax.cumsum(log_not, axis=3, reverse=True) - log_not
        w = jnp.where(mask, jnp.exp(log_beta + log_between), 0.0)
        return jnp.einsum('bhqk,bhkd->bhqd', w.astype(v.dtype), v)

    out = lax.map(block, (_query_blocks(q), jnp.arange(s_len // Q_BLOCK)))
    return _unblock(out)


def _forgetting_attention(q, k, v, log_f):
    b, h, s_len, d = q.shape
    scale = d ** -0.5
    key_pos = jnp.arange(s_len)
    c = lax.cumsum(log_f.astype(jnp.float32), axis=2)
    neg = jnp.finfo(jnp.float32).min

    def block(args):
        qb, cb, i = args
        z = jnp.einsum('bhqd,bhkd->bhqk', qb, k).astype(jnp.float32) * scale
        z = z + cb[..., :, None] - c[..., None, :]
        q_pos = i * Q_BLOCK + jnp.arange(Q_BLOCK)
        mask = key_pos[None, :] <= q_pos[:, None]
        p = jax.nn.softmax(jnp.where(mask, z, neg), axis=-1)
        return jnp.einsum('bhqk,bhkd->bhqd', p.astype(v.dtype), v)

    out = lax.map(block, (_query_blocks(q), _query_blocks(c), jnp.arange(s_len // Q_BLOCK)))
    return _unblock(out)


def _memory_attention(q, k, v):
    z = jnp.einsum('bhqd,bhkd->bhqk', q, k).astype(jnp.float32) * (q.shape[-1] ** -0.5)
    p = jax.nn.softmax(z, axis=-1)
    return jnp.einsum('bhqk,bhkd->bhqd', p.astype(v.dtype), v)


def setup_inputs(seed: int = 0) -> dict:
    key = jax.random.key(seed)
    ks = jax.random.split(key, 32)
    L = DEPTH

    def w(k, shape, fan_in):
        return jax.random.normal(k, shape, jnp.float32) * (fan_in ** -0.5)

    def gain(k, shape):
        return 1.0 + 0.05 * jax.random.normal(k, shape, jnp.float32)

    return {
        'x': jax.random.normal(ks[0], (BATCH, SEQ, D_MODEL), jnp.float32),
        'mem': jax.random.normal(ks[1], (BATCH, MEM_LEN, D_MODEL), jnp.float32),
        'ffn1_pre_g': gain(ks[2], (L, D_MODEL)),
        'ffn1_post_g': gain(ks[3], (L, D_MODEL)),
        'ffn1_w_gate': w(ks[4], (L, D_MODEL, D_FF), D_MODEL),
        'ffn1_w_up': w(ks[5], (L, D_MODEL, D_FF), D_MODEL),
        'ffn1_w_down': w(ks[6], (L, D_FF, D_MODEL), D_FF),
        'mix_pre_g': gain(ks[7], (L, D_MODEL)),
        'mix_post_g': gain(ks[8], (L, D_MODEL)),
        'w_in': w(ks[9], (L, D_MODEL, IN_W), D_MODEL),
        'b_forget': 2.0 + 0.5 * jax.random.normal(ks[10], (L, N_FOX_HEADS), jnp.float32),
        'mem_norm_g': gain(ks[11], (D_MODEL,)),
        'w_mem_kv': w(ks[12], (L, D_MODEL, 2 * MEM_W), D_MODEL),
        'w_gate': w(ks[13], (L, D_MODEL, N_BRANCH * D_MODEL), D_MODEL),
        'b_gate': 0.02 * jax.random.normal(ks[14], (L, N_BRANCH * D_MODEL), jnp.float32),
        'w_br_sb': w(ks[15], (L, SB_W, D_MODEL), SB_W),
        'w_br_fox': w(ks[16], (L, FOX_W, D_MODEL), FOX_W),
        'w_br_mem': w(ks[17], (L, MEM_W, D_MODEL), MEM_W),
        'w_out': w(ks[18], (L, D_MODEL, D_MODEL), D_MODEL),
        'ffn2_pre_g': gain(ks[19], (L, D_MODEL)),
        'ffn2_post_g': gain(ks[20], (L, D_MODEL)),
        'ffn2_w_gate': w(ks[21], (L, D_MODEL, D_FF), D_MODEL),
        'ffn2_w_up': w(ks[22], (L, D_MODEL, D_FF), D_MODEL),
        'ffn2_w_down': w(ks[23], (L, D_FF, D_MODEL), D_FF),
    }


def reference(x, mem, ffn1_pre_g, ffn1_post_g, ffn1_w_gate, ffn1_w_up, ffn1_w_down,
              mix_pre_g, mix_post_g, w_in, b_forget, mem_norm_g, w_mem_kv, w_gate, b_gate,
              w_br_sb, w_br_fox, w_br_mem, w_out,
              ffn2_pre_g, ffn2_post_g, ffn2_w_gate, ffn2_w_up, ffn2_w_down):
    mem_n = _rmsnorm(mem, mem_norm_g)
    split_at = np.cumsum([SB_W, SB_W, SB_W, FOX_W, FOX_W, FOX_W, N_FOX_HEADS])
    h = x
    for l in range(DEPTH):
        f = _swiglu(_rmsnorm(h, ffn1_pre_g[l]), ffn1_w_gate[l], ffn1_w_up[l], ffn1_w_down[l])
        h = h + 0.5 * _rmsnorm(f, ffn1_post_g[l])

        u = _rmsnorm(h, mix_pre_g[l])
        proj = u @ w_in[l]
        q_sb, k_sb, v_sb, q_fx, k_fx, v_fx, f_logit, q_mem = jnp.split(proj, split_at, axis=-1)

        o_sb = _stick_breaking_attention(_split_heads(q_sb, N_SB_HEADS), _split_heads(k_sb, N_SB_HEADS),
                                         _split_heads(v_sb, N_SB_HEADS))
        log_f = jax.nn.log_sigmoid((f_logit + b_forget[l]).astype(jnp.float32)).transpose(0, 2, 1)
        o_fx = _forgetting_attention(_split_heads(q_fx, N_FOX_HEADS), _split_heads(k_fx, N_FOX_HEADS),
                                     _split_heads(v_fx, N_FOX_HEADS), log_f)
        k_mem, v_mem = jnp.split(mem_n @ w_mem_kv[l], 2, axis=-1)
        o_mem = _memory_attention(_split_heads(q_mem, N_MEM_HEADS), _split_heads(k_mem, N_MEM_HEADS),
                                  _split_heads(v_mem, N_MEM_HEADS))

        g_sb, g_fx, g_mem = jnp.split(jax.nn.sigmoid(u @ w_gate[l] + b_gate[l]), N_BRANCH, axis=-1)
        merged = (g_sb * (_merge_heads(o_sb) @ w_br_sb[l])
                  + g_fx * (_merge_heads(o_fx) @ w_br_fox[l])
                  + g_mem * (_merge_heads(o_mem) @ w_br_mem[l]))
        h = h + _rmsnorm(merged @ w_out[l], mix_post_g[l])

        f = _swiglu(_rmsnorm(h, ffn2_pre_g[l]), ffn2_w_gate[l], ffn2_w_up[l], ffn2_w_down[l])
        h = h + 0.5 * _rmsnorm(f, ffn2_post_g[l])
    return h
```

```cpp
#include <hip/hip_runtime.h>
#include <hip/hip_cooperative_groups.h>
#include <cstdio>
#include <cstdint>
namespace cg = cooperative_groups;

#define LAS __attribute__((address_space(3)))
typedef unsigned short bf16_t;
typedef short bf16x8 __attribute__((ext_vector_type(8)));
typedef short s16x4 __attribute__((ext_vector_type(4)));
typedef float f32x4 __attribute__((ext_vector_type(4)));
typedef float f32x2 __attribute__((ext_vector_type(2)));
typedef float f32x16 __attribute__((ext_vector_type(16)));
typedef unsigned u32x4 __attribute__((ext_vector_type(4)));
typedef unsigned u32x2 __attribute__((ext_vector_type(2)));

constexpr int GRIDC = 256;
constexpr int DM = 1024, NB = 4, SEQ = 4096, DEPTH = 4, MEML = 256, T = NB * SEQ;
constexpr int DFF = 2816, INW = 3592, PW = 3584  , GW = 3072;
constexpr float LOG2E = 1.4426950408889634f;
constexpr size_t SLOTB = (size_t)256 * PW * 2;
constexpr float RMS_EPS = 1e-6f;

constexpr size_t MiB = 1u << 20;
constexpr size_t WS_CTL = 0;
constexpr size_t WS_WGU1 = 1 * MiB;
constexpr size_t WS_WD1 = 12 * MiB;
constexpr size_t WS_WIG = 18 * MiB;
constexpr size_t WS_WBR = 31 * MiB;
constexpr size_t WS_WOUT = 34 * MiB;
constexpr size_t WS_WGU2 = 36 * MiB;
constexpr size_t WS_WD2 = 47 * MiB;
constexpr size_t WS_WMKV = 53 * MiB;
constexpr size_t WS_KVMEM = 61 * MiB;
constexpr size_t WS_MEMN = 69 * MiB;
constexpr size_t WS_LOGF = 71 * MiB;
constexpr size_t WS_KN2 = 71 * MiB + 512 * 1024;
constexpr size_t WS_XN = 72 * MiB;
constexpr size_t WS_F = 104 * MiB;
constexpr size_t WS_PROJ = 136 * MiB;
constexpr size_t WS_G = 248 * MiB;
constexpr size_t WS_O = 344 * MiB;
constexpr size_t WS_WSET1 = 391 * MiB;
constexpr size_t WS_END = 444 * MiB;

typedef __bf16 bf16x2_t __attribute__((ext_vector_type(2)));
__device__ __forceinline__ unsigned cvt_pk_bf16(float lo, float hi) { f32x2 v = {lo, hi}; bf16x2_t b = __builtin_convertvector(v, bf16x2_t); return __builtin_bit_cast(unsigned, b); }
__device__ __forceinline__ float bf_lo(unsigned w) { return __uint_as_float(w << 16); }
__device__ __forceinline__ float bf_hi(unsigned w) { return __uint_as_float(w & 0xffff0000u); }
__device__ __forceinline__ float wave_sum(float v) {
#pragma unroll
    for (int o = 1; o < 64; o <<= 1) v += __shfl_xor(v, o);
    return v;
}
__device__ __forceinline__ float fast_exp2(float x) { return __builtin_amdgcn_exp2f(x); }
__device__ __forceinline__ float fast_log2(float x) { return __builtin_amdgcn_logf(x); }
__device__ __forceinline__ float fast_rcp(float x) { return __builtin_amdgcn_rcpf(x); }

namespace pg8 {
constexpr int BM = 256, BK = 64, HALF = 128, HTB = HALF * BK * 2, STAGE_BYTES = 8 * HTB, NXCD = 8, WGM = 8;
__host__ __device__ __forceinline__ int lds_byte(int r, int c) { const int st = (r >> 4) * 2 + (c >> 5), rr = r & 15, cc = c & 31, ob = rr * 64 + cc * 2; return st * 1024 + (ob ^ (((ob >> 9) & 1) << 5)); }
__host__ __device__ __forceinline__ void stage_rc(int b, int& R, int& C) { const int st = b / 1024, sb = b % 1024, swz = sb ^ (((sb >> 9) & 1) << 5); R = (st >> 1) * 16 + swz / 64; C = (st & 1) * 32 + (swz % 64) / 2; }
__host__ __device__ __forceinline__ int perm32(int rho) { const int n = rho >> 4, i = rho & 15; return 8 * (i >> 2) + 4 * n + (i & 3); }

struct Unit { int pm, pn, z; };
struct Gemm { const bf16_t* A; const bf16_t* Bt; int K; size_t zA, zB; };

struct Sched {
    int nM, nN, nZ, G, c; bool zinner;
    __device__ void init(int M, int N, int Z, bool zi, int G_, int c_) { nM = M / BM; nN = N / BM; nZ = Z; zinner = zi; G = G_; c = c_; }
    __device__ bool next(int i, Unit& u) const {
        const int nwg = nM * nN; int L, z;
        if (zinner) { z = i % nZ; L = (i / nZ) * G + c; if (L >= nwg) return false; }
        else { const long LL = (long)i * G + c; if (LL >= (long)nwg * nZ) return false; z = (int)(LL / nwg); L = (int)(LL % nwg); }
        int wgid = L; { const int q = nwg / NXCD, r = nwg % NXCD, xcd = wgid % NXCD, off = wgid / NXCD; wgid = (xcd < r ? xcd * (q + 1) : r * (q + 1) + (xcd - r) * q) + off; }
        const int nig = WGM * nN, gid = wgid / nig, fm = gid * WGM, gsz = (nM - fm) < WGM ? (nM - fm) : WGM;
        u.pm = fm + ((wgid % nig) % gsz); u.pn = (wgid % nig) / gsz; u.z = z; return true;
    }
};

#define ACC_T const f32x4 (&acc)[2][2][4][2]

struct EpiStore {
    bf16_t* O; int ldc; size_t zO;
    __device__ __forceinline__ void operator()(ACC_T, const Unit& u, int wr, int wc, int fr, int fq) const {
        const int row0 = u.pm * BM + wr * 64 + fr, col0 = u.pn * BM + wc * 32 + 8 * fq; bf16_t* base = O + (size_t)u.z * zO;
#pragma unroll
        for (int ai = 0; ai < 2; ++ai)
#pragma unroll
            for (int m = 0; m < 4; ++m) { bf16_t* rowp = base + (size_t)(row0 + ai * HALF + m * 16) * ldc + col0;
#pragma unroll
                for (int bj = 0; bj < 2; ++bj) { const f32x4 v0 = acc[ai][bj][m][0], v1 = acc[ai][bj][m][1];
                    u32x4 w; w.x = cvt_pk_bf16(v0[0], v0[1]); w.y = cvt_pk_bf16(v0[2], v0[3]); w.z = cvt_pk_bf16(v1[0], v1[1]); w.w = cvt_pk_bf16(v1[2], v1[3]);
                    *(u32x4*)(rowp + bj * HALF) = w; } }
    }
};
struct EpiSwiglu {
    bf16_t* H;
    __device__ __forceinline__ void operator()(ACC_T, const Unit& u, int wr, int wc, int fr, int fq) const {
        const int row0 = wr * 64 + fr, col0 = u.pn * HALF + wc * 32 + 8 * fq; bf16_t* Hp = H + (size_t)u.pm * (SLOTB / 2);
#pragma unroll
        for (int ai = 0; ai < 2; ++ai)
#pragma unroll
            for (int m = 0; m < 4; ++m) { bf16_t* rowp = Hp + (size_t)(row0 + ai * HALF + m * 16) * DFF + col0; float r[8];
#pragma unroll
                for (int n = 0; n < 2; ++n)
#pragma unroll
                    for (int e = 0; e < 4; ++e) { const float g = acc[ai][0][m][n][e], up = acc[ai][1][m][n][e]; r[n * 4 + e] = g * fast_rcp(1.f + fast_exp2(-g * LOG2E)) * up; }
                u32x4 w; w.x = cvt_pk_bf16(r[0], r[1]); w.y = cvt_pk_bf16(r[2], r[3]); w.z = cvt_pk_bf16(r[4], r[5]); w.w = cvt_pk_bf16(r[6], r[7]);
                *(u32x4*)rowp = w; }
    }
};
struct EpiIG {
    bf16_t* P; bf16_t* Gt; const float* bias; float* kn2;
    __device__ __forceinline__ void operator()(ACC_T, const Unit& u, int wr, int wc, int fr, int fq) const {
        const int row0 = u.pm * BM + wr * 64 + fr, cw = wc * 32 + 8 * fq;
        if (u.pn < 14) {
            float sc = 1.f; if (u.pn < 2 || u.pn == 6 || u.pn == 7) sc = 0.125f * LOG2E; else if (u.pn >= 12) sc = 0.08838834764831845f * LOG2E;
            const int col0 = u.pn * BM + cw;
#pragma unroll
            for (int ai = 0; ai < 2; ++ai)
#pragma unroll
                for (int m = 0; m < 4; ++m) { bf16_t* rowp = P + (size_t)(row0 + ai * HALF + m * 16) * PW + col0;
#pragma unroll
                    for (int bj = 0; bj < 2; ++bj) { const f32x4 v0 = acc[ai][bj][m][0] * sc, v1 = acc[ai][bj][m][1] * sc;
                        u32x4 w; w.x = cvt_pk_bf16(v0[0], v0[1]); w.y = cvt_pk_bf16(v0[2], v0[3]); w.z = cvt_pk_bf16(v1[0], v1[1]); w.w = cvt_pk_bf16(v1[2], v1[3]);
                        *(u32x4*)(rowp + bj * HALF) = w;
                        if (u.pn == 8 || u.pn == 9) {
                            float q = (v0[0] * v0[0] + v0[1] * v0[1]) + (v0[2] * v0[2] + v0[3] * v0[3]) + (v1[0] * v1[0] + v1[1] * v1[1]) + (v1[2] * v1[2] + v1[3] * v1[3]);
                            q += __shfl_xor(q, 16); q += __shfl_xor(q, 32);
                            if (fq == 0) __hip_atomic_fetch_add(kn2 + (size_t)((u.pn - 8) * 4 + bj * 2 + (wc >> 1)) * T + (row0 + ai * HALF + m * 16), q, __ATOMIC_RELAXED, __HIP_MEMORY_SCOPE_AGENT); } } }
        } else {
            const int col0 = (u.pn - 14) * BM + cw;
            f32x4 bv[2][2];
#pragma unroll
            for (int bj = 0; bj < 2; ++bj)
#pragma unroll
                for (int n = 0; n < 2; ++n) bv[bj][n] = *(const f32x4*)(bias + col0 + bj * HALF + 4 * n);
#pragma unroll
            for (int ai = 0; ai < 2; ++ai)
#pragma unroll
                for (int m = 0; m < 4; ++m) { bf16_t* rowp = Gt + (size_t)(row0 + ai * HALF + m * 16) * GW + col0;
#pragma unroll
                    for (int bj = 0; bj < 2; ++bj) { float r[8];
#pragma unroll
                        for (int n = 0; n < 2; ++n)
#pragma unroll
                            for (int e = 0; e < 4; ++e) { const float x = acc[ai][bj][m][n][e] + bv[bj][n][e]; r[n * 4 + e] = fast_rcp(1.f + fast_exp2(-x * LOG2E)); }
                        u32x4 w; w.x = cvt_pk_bf16(r[0], r[1]); w.y = cvt_pk_bf16(r[2], r[3]); w.z = cvt_pk_bf16(r[4], r[5]); w.w = cvt_pk_bf16(r[6], r[7]);
                        *(u32x4*)(rowp + bj * HALF) = w; } }
        }
    }
};
struct EpiBranch {
    const bf16_t* Gt; float* M32; bf16_t* MG;
    __device__ __forceinline__ void operator()(ACC_T, const Unit& u, int wr, int wc, int fr, int fq) const {
        const int row0 = u.pm * BM + wr * 64 + fr, col0 = u.pn * BM + wc * 32 + 8 * fq;
#pragma unroll
        for (int ai = 0; ai < 2; ++ai)
#pragma unroll
            for (int m = 0; m < 4; ++m) { const size_t row = (size_t)(row0 + ai * HALF + m * 16);
#pragma unroll
                for (int bj = 0; bj < 2; ++bj) {
                    const u32x4 gw = *(const u32x4*)(Gt + row * GW + u.z * DM + col0 + bj * HALF);
                    f32x4 v0 = acc[ai][bj][m][0], v1 = acc[ai][bj][m][1];
                    v0[0] *= bf_lo(gw.x); v0[1] *= bf_hi(gw.x); v0[2] *= bf_lo(gw.y); v0[3] *= bf_hi(gw.y);
                    v1[0] *= bf_lo(gw.z); v1[1] *= bf_hi(gw.z); v1[2] *= bf_lo(gw.w); v1[3] *= bf_hi(gw.w);
                    float* mp = M32 + (size_t)u.pm * (SLOTB / 4) + (row - (size_t)u.pm * BM) * DM + col0 + bj * HALF;
                    if (u.z > 0) { v0 += *(const f32x4*)mp; v1 += *(const f32x4*)(mp + 4); }
                    if (u.z < 2) { *(f32x4*)mp = v0; *(f32x4*)(mp + 4) = v1; }
                    else { u32x4 w; w.x = cvt_pk_bf16(v0[0], v0[1]); w.y = cvt_pk_bf16(v0[2], v0[3]); w.z = cvt_pk_bf16(v1[0], v1[1]); w.w = cvt_pk_bf16(v1[2], v1[3]);
                        *(u32x4*)(MG + row * DM + col0 + bj * HALF) = w; } } }
    }
};

template <class Epi, bool ALIGN_EPI, bool ASLOT = false>
__device__ __forceinline__ void gemm_phase(LAS unsigned char* lds, const Gemm g, const Sched& S, const Epi& E) {
    int tid_ = threadIdx.x; asm volatile("" : "+v"(tid_));
    const int tid = tid_, wid = __builtin_amdgcn_readfirstlane(tid >> 6), lane = tid & 63, wr = wid >> 2, wc = wid & 3, fr = lane & 15, fq = lane >> 4;
    const int K = g.K, nt = K / BK;
    unsigned voffA[2], voffB[2];
#pragma unroll
    for (int i = 0; i < 2; ++i) { int R, C; stage_rc(tid * 16 + i * 8192, R, C); const int Rb = (R & ~31) + perm32(R & 31);
        voffA[i] = (unsigned)(R * K + C) * 2u; voffB[i] = (unsigned)(Rb * K + C) * 2u; }
    const size_t kstep = (size_t)(BK * 2);
    const size_t hstep = (size_t)HALF * K * 2;
    const size_t tstep = 2 * hstep;
    const unsigned ldsw = (unsigned)wid * 1024u;
    const int aoff = lds_byte(wr * 64 + fr, fq * 8), boff = lds_byte(wc * 32 + fr, fq * 8);
#define PG8_SA(b, h) (((b) * 2 + (h)) * HTB)
#define PG8_SB(b, h) ((4 + (b) * 2 + (h)) * HTB)
#define PG8_STAGE(bufoff, gbase, voff) do { _Pragma("unroll") for (int _i = 0; _i < 2; ++_i) \
        __builtin_amdgcn_global_load_lds((const unsigned*)((const char*)(gbase) + (voff)[_i]), (LAS unsigned*)(lds + (bufoff) + ldsw + _i * 8192), 16, 0, 0); } while (0)
#define PG8_LDA(dst, b, h) do { _Pragma("unroll") for (int m = 0; m < 4; ++m) _Pragma("unroll") for (int k = 0; k < 2; ++k) dst[m][k] = *(const LAS bf16x8*)(lds + PG8_SA(b, h) + aoff + m * 2048 + k * 1024); } while (0)
#define PG8_LDB(dst, b, h) do { _Pragma("unroll") for (int n = 0; n < 2; ++n) _Pragma("unroll") for (int k = 0; k < 2; ++k) dst[n][k] = *(const LAS bf16x8*)(lds + PG8_SB(b, h) + boff + n * 2048 + k * 1024); } while (0)
#define PG8_MMA(ai, bj, At, Bt) do { __builtin_amdgcn_s_setprio(1); _Pragma("unroll") for (int m = 0; m < 4; ++m) _Pragma("unroll") for (int n = 0; n < 2; ++n) _Pragma("unroll") for (int k = 0; k < 2; ++k) \
        acc[ai][bj][m][n] = __builtin_amdgcn_mfma_f32_16x16x32_bf16(Bt[n][k], At[m][k], acc[ai][bj][m][n], 0, 0, 0); __builtin_amdgcn_s_setprio(0); } while (0)
#define PG8_WAIT_V(n) asm volatile("s_waitcnt vmcnt(" #n ")" ::: "memory")
#define PG8_WAIT_L(n) asm volatile("s_waitcnt lgkmcnt(" #n ")" ::: "memory")
#define PG8_BAR __builtin_amdgcn_s_barrier()
#define PG8_SCHED __builtin_amdgcn_sched_barrier(0)
    Unit cur, nxt; int ui = 0;
    if (!S.next(0, cur)) return;
    f32x4 acc[2][2][4][2];
#pragma unroll
    for (int a = 0; a < 2; ++a)
#pragma unroll
        for (int b = 0; b < 2; ++b)
#pragma unroll
            for (int m = 0; m < 4; ++m)
#pragma unroll
                for (int n = 0; n < 2; ++n) acc[a][b][m][n] = (f32x4){0.f, 0.f, 0.f, 0.f};
    bf16x8 At[4][2], B0[2][2], B1[2][2];
    const size_t pstepA = ASLOT ? SLOTB : tstep;
    const char* cA = (const char*)g.A + (size_t)cur.z * g.zA + (size_t)cur.pm * pstepA; const char* cB = (const char*)g.Bt + (size_t)cur.z * g.zB + (size_t)cur.pn * tstep;
    PG8_STAGE(PG8_SB(0, 0), cB, voffB); PG8_STAGE(PG8_SB(0, 1), cB + hstep, voffB); PG8_STAGE(PG8_SA(0, 0), cA, voffA); PG8_STAGE(PG8_SA(0, 1), cA + hstep, voffA);
    if (wr == 1) PG8_BAR;
    PG8_WAIT_V(2); PG8_BAR;
    PG8_STAGE(PG8_SB(1, 0), cB + kstep, voffB); PG8_STAGE(PG8_SA(1, 0), cA + kstep, voffA); PG8_STAGE(PG8_SB(1, 1), cB + hstep + kstep, voffB);
    PG8_WAIT_V(6); PG8_BAR;
    for (;;) {
        const bool has_next = S.next(ui + 1, nxt);
        const char* nA = has_next ? (const char*)g.A + (size_t)nxt.z * g.zA + (size_t)nxt.pm * pstepA : cA; const char* nB = has_next ? (const char*)g.Bt + (size_t)nxt.z * g.zB + (size_t)nxt.pn * tstep : cB;
        for (int t = 0; t < nt; t += 2) {
            const bool last = (t == nt - 2);
            const char* a1 = cA + (size_t)(t + 1) * kstep;
            const char* a2 = last ? nA : cA + (size_t)(t + 2) * kstep; const char* b2 = last ? nB : cB + (size_t)(t + 2) * kstep;
            const char* a3 = a2 + kstep; const char* b3 = b2 + kstep;
            PG8_LDB(B0, 0, 0); PG8_LDB(B1, 0, 1); PG8_SCHED; PG8_LDA(At, 0, 0); PG8_STAGE(PG8_SA(1, 1), a1 + hstep, voffA);
            PG8_WAIT_V(8); PG8_WAIT_L(0); PG8_BAR; PG8_MMA(0, 0, At, B0); PG8_MMA(0, 1, At, B1); PG8_BAR; PG8_SCHED;
            PG8_LDA(At, 0, 1); PG8_STAGE(PG8_SB(0, 0), b2, voffB); PG8_STAGE(PG8_SB(0, 1), b2 + hstep, voffB); PG8_STAGE(PG8_SA(0, 0), a2, voffA);
            PG8_WAIT_V(8); PG8_WAIT_L(0); PG8_BAR; PG8_MMA(1, 0, At, B0); PG8_MMA(1, 1, At, B1); PG8_BAR; PG8_SCHED;
            PG8_LDB(B0, 1, 0); PG8_LDB(B1, 1, 1); PG8_SCHED; PG8_LDA(At, 1, 0); PG8_STAGE(PG8_SA(0, 1), a2 + hstep, voffA);
            PG8_WAIT_V(8); PG8_WAIT_L(0); PG8_BAR; PG8_MMA(0, 0, At, B0); PG8_MMA(0, 1, At, B1); PG8_BAR; PG8_SCHED;
            PG8_LDA(At, 1, 1); PG8_STAGE(PG8_SB(1, 0), b3, voffB); PG8_STAGE(PG8_SB(1, 1), b3 + hstep, voffB); PG8_STAGE(PG8_SA(1, 0), a3, voffA);
            PG8_WAIT_V(8); PG8_WAIT_L(0); PG8_BAR; PG8_MMA(1, 0, At, B0); PG8_MMA(1, 1, At, B1); PG8_BAR; PG8_SCHED;
        }
        if constexpr (ALIGN_EPI) { if (wr == 0) PG8_BAR; }
        E(acc, cur, wr, wc, fr, fq);
        if (!has_next) break;
#pragma unroll
        for (int a = 0; a < 2; ++a)
#pragma unroll
            for (int b = 0; b < 2; ++b)
#pragma unroll
                for (int m = 0; m < 4; ++m)
#pragma unroll
                    for (int n = 0; n < 2; ++n) acc[a][b][m][n] = (f32x4){0.f, 0.f, 0.f, 0.f};
        cur = nxt; cA = nA; cB = nB; ++ui;
        if constexpr (ALIGN_EPI) { if (wr == 1) PG8_BAR; }
    }
    PG8_WAIT_V(0);
    if constexpr (!ALIGN_EPI) { if (wr == 0) PG8_BAR; }
    PG8_BAR;
#undef PG8_SA
#undef PG8_SB
#undef PG8_STAGE
#undef PG8_LDA
#undef PG8_LDB
#undef PG8_MMA
#undef PG8_WAIT_V
#undef PG8_WAIT_L
#undef PG8_BAR
#undef PG8_SCHED
}
}

namespace att {
constexpr int L_CS = 65536, L_FLAG = 131072, L_QW = 131072 + 128, L_WS = 131328, L_END = 133376;
constexpr float SB_THR = -152.0f;
__device__ __forceinline__ int crow(int r, int hi) { return (r & 3) + 8 * (r >> 2) + 4 * hi; }
#define SBAR() __builtin_amdgcn_sched_barrier(0)
#define WAIT_BAR0() asm volatile("s_waitcnt vmcnt(0) lgkmcnt(0)\n\ts_barrier" ::: "memory")
__device__ __forceinline__ void glds16(const void* gsrc, unsigned lds_dst) { unsigned keep;
    asm volatile("s_mov_b32 %0, m0\n\ts_mov_b32 m0, %2\n\ts_nop 0\n\tglobal_load_lds_dwordx4 %1, off\n\ts_mov_b32 m0, %0" : "=&s"(keep) : "v"(gsrc), "s"(lds_dst) : "memory"); }
__device__ __forceinline__ float swap_other(float x, int hi, float& sum) {
    auto rr = __builtin_amdgcn_permlane32_swap(__float_as_uint(x), __float_as_uint(x), false, false);
    const float a = __uint_as_float(rr[0]), b = __uint_as_float(rr[1]); sum = a + b; return hi ? a : b; }

template <int MODE, int HD>
__device__ __forceinline__ unsigned attn_unit(const bf16_t* Qb, const bf16_t* Kb, const bf16_t* Vb, int pq, int pk, bf16_t* Ob, int q0, const float* logf, unsigned char* shm, unsigned* qctr) {
    constexpr int ND = HD / 16, NO = HD / 32, NP = HD / 64, SLOT = 64 * HD * 2, L_V = 4 * SLOT;
    int tid_ = threadIdx.x; asm volatile("" : "+v"(tid_));
    const int tid = tid_, lane = tid & 63, r32 = lane & 31, hi = lane >> 5; const int wid = __builtin_amdgcn_readfirstlane(tid >> 6);
    const unsigned lds0 = (unsigned)(uintptr_t)shm;
    LAS unsigned char* shl = (LAS unsigned char*)(unsigned)(uintptr_t)shm;
    LAS float* wsf = (LAS float*)(shl + L_WS) + wid * 64;
    LAS float* CS = (LAS float*)(shl + L_CS);
    LAS unsigned* FLG = (LAS unsigned*)(shl + L_FLAG);
    const int T0 = (MODE == 2) ? 3 : (q0 + 256) / 64 - 1;
    const int tw = (MODE == 2) ? 3 : q0 / 64 + (wid >> 1);
    const int qg = q0 + 32 * wid + r32;
#define DMA_TILE(t, sl) do { _Pragma("unroll") for (int p_ = 0; p_ < NP; ++p_) { const int c_ = wid + 8 * p_; \
        glds16(Kb + (size_t)(64 * (t) + lane) * pk + c_ * 8, (unsigned)__builtin_amdgcn_readfirstlane(lds0 + (sl) * SLOT + c_ * 1024)); \
        glds16(Vb + (size_t)(64 * (t) + 16 * (c_ & 3) + (lane >> 2)) * pk + (c_ >> 2) * 32 + (lane & 3) * 8, (unsigned)__builtin_amdgcn_readfirstlane(lds0 + L_V + (sl) * SLOT + c_ * 1024)); } } while (0)
    bf16x8 qr[ND];
#pragma unroll
    for (int d0 = 0; d0 < ND; ++d0) qr[d0] = *(const bf16x8*)(Qb + (size_t)qg * pq + d0 * 16 + hi * 8);
    DMA_TILE(T0, 0); if (T0 >= 1) DMA_TILE(T0 - 1, 1); if (T0 >= 2) DMA_TILE(T0 - 2, 2);
    if (MODE == 1) {
        const int n = q0 + 256; float v[8]; float kx[8]; const float* kn = logf + (size_t)T * 8;
#pragma unroll
        for (int j = 0; j < 8; ++j) { v[j] = 0.f; kx[j] = 0.f; }
        if (8 * tid < n) {
            const f32x4 l0 = *(const f32x4*)(logf + 8 * tid), l1 = *(const f32x4*)(logf + 8 * tid + 4), k0_ = *(const f32x4*)(kn + 8 * tid), k1_ = *(const f32x4*)(kn + 8 * tid + 4);
            v[0] = l0.x; v[1] = l0.y; v[2] = l0.z; v[3] = l0.w; v[4] = l1.x; v[5] = l1.y; v[6] = l1.z; v[7] = l1.w;
            kx[0] = k0_.x; kx[1] = k0_.y; kx[2] = k0_.z; kx[3] = k0_.w; kx[4] = k1_.x; kx[5] = k1_.y; kx[6] = k1_.z; kx[7] = k1_.w; }
        float run = 0.f, mx = 0.f;
#pragma unroll
        for (int j = 0; j < 8; ++j) { run += v[j]; v[j] = run; mx = __builtin_fmaxf(mx, kx[j]); }
        float sc = run;
#pragma unroll
        for (int o = 1; o < 64; o <<= 1) { const float tt = __shfl_up(sc, o); if (lane >= o) sc += tt; }
        mx = __builtin_fmaxf(mx, __shfl_xor(mx, 1)); mx = __builtin_fmaxf(mx, __shfl_xor(mx, 2)); mx = __builtin_fmaxf(mx, __shfl_xor(mx, 4));
        LAS float* TM = CS + 4096; LAS float* PM = CS + 4096 + 64;
        if (lane == 63) wsf[0] = sc;
        if ((lane & 7) == 0) TM[tid >> 3] = mx;
        asm volatile("s_waitcnt lgkmcnt(0)\n\ts_barrier" ::: "memory");
        float base = 0.f;
#pragma unroll
        for (int w = 0; w < 8; ++w) { const float wt = ((LAS float*)(shl + L_WS))[w * 64]; if (w < wid) base += wt; }
        base += sc - run;
        if (8 * tid < n) {
#pragma unroll
            for (int j = 0; j < 8; ++j) CS[8 * tid + j] = -(base + v[j]);
        }
        if (tid < 64) {
            float pm = TM[tid];
#pragma unroll
            for (int o = 1; o < 64; o <<= 1) { const float tt = __shfl_up(pm, o); if (lane >= o) pm = __builtin_fmaxf(pm, tt); }
            PM[tid] = sqrtf(pm) * 1.01f; }
        asm volatile("s_waitcnt lgkmcnt(0)\n\ts_barrier" ::: "memory");
    }
    float qn = 0.f;
    if (MODE == 1) {
#pragma unroll
        for (int d0 = 0; d0 < ND; ++d0)
#pragma unroll
            for (int e = 0; e < 8; ++e) { const float qv = __uint_as_float(((unsigned)(unsigned short)qr[d0][e]) << 16); qn += qv * qv; }
        float qs; (void)swap_other(qn, hi, qs); qn = sqrtf(qs) * 1.01f;
    }
    float mrow = -INFINITY, lrow = 0.f, R = 0.f; bool wdone = false;
    f32x16 o[NO];
#pragma unroll
    for (int d = 0; d < NO; ++d) o[d] = f32x16{};
    const LAS unsigned char* kp0 = shl + hi * 1024 + r32 * 16;
    const int vb0 = (int)(lds0 + L_V) + ((lane >> 4) & 1) * 32 + (lane & 3) * 8 + (4 * hi + ((lane & 15) >> 2)) * 64;
    for (int it = 0; it <= T0; ++it) {
        const int t = T0 - it, sl = it & 3;
        { const int ahead = T0 - it;
          if (ahead >= 2) { if (NP == 1) asm volatile("s_waitcnt vmcnt(4) lgkmcnt(0)\n\ts_barrier" ::: "memory"); else asm volatile("s_waitcnt vmcnt(8) lgkmcnt(0)\n\ts_barrier" ::: "memory"); }
          else if (ahead == 1) { if (NP == 1) asm volatile("s_waitcnt vmcnt(2) lgkmcnt(0)\n\ts_barrier" ::: "memory"); else asm volatile("s_waitcnt vmcnt(4) lgkmcnt(0)\n\ts_barrier" ::: "memory"); }
          else WAIT_BAR0(); }
        if ((MODE == 0 || MODE == 1) && it > 0) {
            const u32x4 f0 = *(const LAS u32x4*)(FLG + ((it - 1) & 1) * 8), f1 = *(const LAS u32x4*)(FLG + ((it - 1) & 1) * 8 + 4);
            if ((f0.x & f0.y & f0.z & f0.w & f1.x & f1.y & f1.z & f1.w) != 0u) break;
        }
        if (t >= 3) DMA_TILE(t - 3, (it + 3) & 3);
        if (t <= tw && !wdone) {
            const bool diag = (t == tw) && (MODE != 2);
            f32x16 p0 = f32x16{}, p1 = f32x16{};
            if (MODE == 1) {
#pragma unroll
                for (int g = 0; g < 4; ++g) { const f32x4 c4 = *(const LAS f32x4*)(CS + 64 * t + 8 * g + 4 * hi), d4 = *(const LAS f32x4*)(CS + 64 * t + 32 + 8 * g + 4 * hi);
#pragma unroll
                    for (int j = 0; j < 4; ++j) { p0[4 * g + j] = c4[j]; p1[4 * g + j] = d4[j]; } }
            }
            { const LAS unsigned char* kb = kp0 + sl * SLOT;
#pragma unroll
              for (int d0 = 0; d0 < ND; ++d0) { const bf16x8 b0 = *(const LAS bf16x8*)(kb + d0 * 2048), b1 = *(const LAS bf16x8*)(kb + d0 * 2048 + 512);
                  p0 = __builtin_amdgcn_mfma_f32_32x32x16_bf16(b0, qr[d0], p0, 0, 0, 0); p1 = __builtin_amdgcn_mfma_f32_32x32x16_bf16(b1, qr[d0], p1, 0, 0, 0); } }
            const int kv0 = 64 * t + 4 * hi;
            const int vb = vb0 + sl * SLOT;
            s16x4 lo[NO][4], hh[NO][4];
#pragma unroll
            for (int d0 = 0; d0 < NO; ++d0)
#pragma unroll
                for (int ks = 0; ks < 4; ++ks) {
                    asm volatile("ds_read_b64_tr_b16 %0,%1 offset:%c2" : "=&v"(lo[d0][ks]) : "v"(vb), "i"(d0 * 4096 + ks * 1024) : "memory");
                    asm volatile("ds_read_b64_tr_b16 %0,%1 offset:%c2" : "=&v"(hh[d0][ks]) : "v"(vb), "i"(d0 * 4096 + ks * 1024 + 512) : "memory"); }
#define XR(i) (((i) < 16) ? p0[(i) & 15] : p1[(i) & 15])
#define XW(i, val) do { if ((i) < 16) p0[(i) & 15] = (val); else p1[(i) & 15] = (val); } while (0)
#define KVL(i) (((i) & 3) + 8 * (((i) & 15) >> 2) + 32 * ((i) >> 4))
            if (MODE == 0) {
                float ln[32];
#pragma unroll
                for (int i = 0; i < 32; ++i) { const float x = XR(i); const float e = fast_exp2(-__builtin_fabsf(x)); const float sp = __builtin_fmaxf(x, 0.f) + fast_log2(1.f + e);
                    const bool valid = !diag || (kv0 + KVL(i) < qg); ln[i] = valid ? -sp : 0.f; XW(i, valid ? x - sp : -INFINITY); }
                float tot[8];
#pragma unroll
                for (int g = 0; g < 8; ++g) { const float e0 = ln[4 * g], e1 = ln[4 * g + 1], e2 = ln[4 * g + 2], e3 = ln[4 * g + 3]; const float s2 = e3, s1 = e3 + e2, s0 = s1 + e1;
                    tot[g] = s0 + e0; ln[4 * g] = s0; ln[4 * g + 1] = s1; ln[4 * g + 2] = s2; ln[4 * g + 3] = 0.f; }
                float pt[8], pair[8];
#pragma unroll
                for (int g = 0; g < 8; ++g) pt[g] = swap_other(tot[g], hi, pair[g]);
                float ps = 0.f; float off[8];
#pragma unroll
                for (int g = 7; g >= 0; --g) { off[g] = R + ps + (hi ? 0.f : pt[g]); ps += pair[g]; }
#pragma unroll
                for (int i = 0; i < 32; ++i) XW(i, fast_exp2(XR(i) + ln[i] + off[i >> 2]));
                R += ps;
            } else {
                if (MODE == 1 && diag) {
#pragma unroll
                    for (int i = 0; i < 32; ++i) { if (kv0 + KVL(i) > qg) XW(i, -INFINITY); }
                }
                float rm = p0[0];
#pragma unroll
                for (int r = 1; r < 16; ++r) rm = __builtin_fmaxf(rm, p0[r]);
#pragma unroll
                for (int r = 0; r < 16; ++r) rm = __builtin_fmaxf(rm, p1[r]);
                { auto rr = __builtin_amdgcn_permlane32_swap(__float_as_uint(rm), __float_as_uint(rm), false, false); rm = __builtin_fmaxf(__uint_as_float(rr[0]), __uint_as_float(rr[1])); }
                const float mnew = __builtin_fmaxf(mrow, rm);
                if (__any(mnew > mrow)) {
                    const float alpha = fast_exp2(mrow - mnew); lrow *= alpha; mrow = mnew;
                    if (hi == 0) wsf[r32] = alpha;
                    asm volatile("s_waitcnt lgkmcnt(0)" ::: "memory");
#pragma unroll
                    for (int r = 0; r < 16; ++r) { const float f = wsf[crow(r, hi)];
#pragma unroll
                        for (int d = 0; d < NO; ++d) o[d][r] *= f; }
                }
                p0 = p0 - mrow; p1 = p1 - mrow;
#pragma unroll
                for (int r = 0; r < 16; ++r) { p0[r] = fast_exp2(p0[r]); p1[r] = fast_exp2(p1[r]); }
                { const f32x16 sv = p0 + p1;
                  typedef float f32x8 __attribute__((ext_vector_type(8)));
                  const f32x8 s8 = __builtin_shufflevector(sv, sv, 0, 1, 2, 3, 4, 5, 6, 7) + __builtin_shufflevector(sv, sv, 8, 9, 10, 11, 12, 13, 14, 15);
                  const f32x4 s4 = __builtin_shufflevector(s8, s8, 0, 1, 2, 3) + __builtin_shufflevector(s8, s8, 4, 5, 6, 7);
                  lrow += (s4[0] + s4[1]) + (s4[2] + s4[3]); }
            }
            u32x4 pw0, pw1, pw2, pw3;
            pw0 = (u32x4){cvt_pk_bf16(p0[0], p0[1]), cvt_pk_bf16(p0[2], p0[3]), cvt_pk_bf16(p0[4], p0[5]), cvt_pk_bf16(p0[6], p0[7])};
            pw1 = (u32x4){cvt_pk_bf16(p0[8], p0[9]), cvt_pk_bf16(p0[10], p0[11]), cvt_pk_bf16(p0[12], p0[13]), cvt_pk_bf16(p0[14], p0[15])};
            pw2 = (u32x4){cvt_pk_bf16(p1[0], p1[1]), cvt_pk_bf16(p1[2], p1[3]), cvt_pk_bf16(p1[4], p1[5]), cvt_pk_bf16(p1[6], p1[7])};
            pw3 = (u32x4){cvt_pk_bf16(p1[8], p1[9]), cvt_pk_bf16(p1[10], p1[11]), cvt_pk_bf16(p1[12], p1[13]), cvt_pk_bf16(p1[14], p1[15])};
            {
                asm volatile("s_waitcnt lgkmcnt(0)" ::: "memory"); SBAR();
#define PK(d, k) (bf16x8){lo[d][k][0], lo[d][k][1], lo[d][k][2], lo[d][k][3], hh[d][k][0], hh[d][k][1], hh[d][k][2], hh[d][k][3]}
#pragma unroll
                for (int d0 = 0; d0 < NO; ++d0) o[d0] = __builtin_amdgcn_mfma_f32_32x32x16_bf16(__builtin_bit_cast(bf16x8, pw0), PK(d0, 0), o[d0], 0, 0, 0);
#pragma unroll
                for (int d0 = 0; d0 < NO; ++d0) o[d0] = __builtin_amdgcn_mfma_f32_32x32x16_bf16(__builtin_bit_cast(bf16x8, pw1), PK(d0, 1), o[d0], 0, 0, 0);
#pragma unroll
                for (int d0 = 0; d0 < NO; ++d0) o[d0] = __builtin_amdgcn_mfma_f32_32x32x16_bf16(__builtin_bit_cast(bf16x8, pw2), PK(d0, 2), o[d0], 0, 0, 0);
#pragma unroll
                for (int d0 = 0; d0 < NO; ++d0) o[d0] = __builtin_amdgcn_mfma_f32_32x32x16_bf16(__builtin_bit_cast(bf16x8, pw3), PK(d0, 3), o[d0], 0, 0, 0);
#undef PK
            }
#undef XR
#undef XW
#undef KVL
        }
        if (MODE == 0) { const bool notdone = (t > tw) || __any(R >= SB_THR); wdone = !notdone; if (lane == 0) FLG[(it & 1) * 8 + wid] = notdone ? 0u : 1u; }
        if (MODE == 1) {
            bool notdone = true;
            if (t <= tw && t >= 1 && !wdone) { const float bound = qn * CS[4096 + 64 + (t - 1)] + CS[64 * t - 1] - mrow;     notdone = __any(!(bound < -153.0f)); }
            if (wdone) notdone = false; wdone = !notdone;
            if (lane == 0) FLG[(it & 1) * 8 + wid] = notdone ? 0u : 1u; }
    }
    WAIT_BAR0();
    unsigned nxt = 0u;
    if (tid == 0) nxt = __hip_atomic_fetch_add(qctr, 1u, __ATOMIC_RELAXED, __HIP_MEMORY_SCOPE_AGENT);
    float rinv = 1.f;
    if (MODE != 0) { float ls; (void)swap_other(lrow, hi, ls); rinv = 1.0f / ls; }
    if (hi == 0) wsf[32 + r32] = rinv;
    asm volatile("s_waitcnt lgkmcnt(0)" ::: "memory");
    float rli[16];
#pragma unroll
    for (int r = 0; r < 16; ++r) rli[r] = wsf[32 + crow(r, hi)];
    LAS bf16_t* stg = (LAS bf16_t*)(shl) + wid * 2048;
    bf16_t* Ow = Ob + (size_t)(q0 + 32 * wid) * 512;
#pragma unroll
    for (int dp = 0; dp < NP; ++dp) {
#pragma unroll
        for (int r = 0; r < 16; ++r) { const int orow = crow(r, hi);
#pragma unroll
            for (int d0 = 0; d0 < 2; ++d0) stg[orow * 64 + d0 * 32 + r32] = (bf16_t)(cvt_pk_bf16(o[2 * dp + d0][r] * rli[r], 0.f) & 0xffffu); }
        asm volatile("s_waitcnt lgkmcnt(0)" ::: "memory");
#pragma unroll
        for (int i = 0; i < 4; ++i) { const int row = i * 8 + (lane >> 3), ch = lane & 7; const u32x4 v = *(const LAS u32x4*)(stg + row * 64 + ch * 8); *(u32x4*)(Ow + (size_t)row * 512 + dp * 64 + ch * 8) = v; }
        asm volatile("s_waitcnt lgkmcnt(0)" ::: "memory");
    }
    WAIT_BAR0();
#undef DMA_TILE
    return nxt;
}
#undef SBAR
#undef WAIT_BAR0
}

struct Args { const float* in[24]; float* out; unsigned char* ws; };
enum { I_X = 0, I_MEM, I_F1PRE, I_F1POST, I_F1G, I_F1U, I_F1D, I_MIXPRE, I_MIXPOST, I_WIN, I_BF, I_MEMG, I_WMKV, I_WGATE, I_BGATE, I_BRSB, I_BRFOX, I_BRMEM, I_WOUT, I_F2PRE, I_F2POST, I_F2G, I_F2U, I_F2D };

__device__ __forceinline__ unsigned f2bf(float f) { unsigned u = __builtin_bit_cast(unsigned, f); return (u + 0x7fffu + ((u >> 16) & 1u)) >> 16; }
__device__ __forceinline__ unsigned pk2(float lo, float hi) { return f2bf(lo) | (f2bf(hi) << 16); }

__device__ __forceinline__ void tr_item(const float* W, int N, int K, int k0, int nsrc0, bf16_t* WT, int drow0, LAS float* scr, int lane) {
    float tv[32];
#pragma unroll
    for (int i = 0; i < 32; ++i) tv[i] = __builtin_nontemporal_load(&W[(size_t)(k0 + 2 * i + (lane >> 5)) * N + nsrc0 + (lane & 31)]);
#pragma unroll
    for (int i = 0; i < 32; ++i) scr[(2 * i + (lane >> 5)) * 33 + (lane & 31)] = tv[i];
    asm volatile("s_waitcnt lgkmcnt(0)" ::: "memory");
    const int c = lane & 7;
#pragma unroll
    for (int j = 0; j < 4; ++j) { const int n = (lane >> 3) + 8 * j; const LAS float* s = scr + (8 * c) * 33 + n;
        u32x4 o; o.x = pk2(s[0 * 33], s[1 * 33]); o.y = pk2(s[2 * 33], s[3 * 33]); o.z = pk2(s[4 * 33], s[5 * 33]); o.w = pk2(s[6 * 33], s[7 * 33]);
        __builtin_nontemporal_store(o, (u32x4*)(WT + (size_t)(drow0 + n) * K + k0 + 8 * c)); }
    asm volatile("s_waitcnt lgkmcnt(0)" ::: "memory");
}
__device__ __forceinline__ void conv_mat(const float* W, int K, int N, int c0, int nc, bf16_t* WT, int mode, int roff, int& base, int gw, int NGW, LAS float* scr, int lane) {
    const int nblk = nc / 32, nitems = (K / 64) * nblk;
    int first = (gw - base) % NGW; if (first < 0) first += NGW;
    for (int it = first; it < nitems; it += NGW) { const int kb = it / nblk, nb = it % nblk, n = 32 * nb;
        const int drow = mode ? ((n >> 7) * 256 + roff + (n & 127)) : (roff + n);
        tr_item(W, N, K, 64 * kb, c0 + n, WT, drow, scr, lane); }
    base += nitems;
}

struct Frame { LAS unsigned char* lds; unsigned char* ws; int tid, lane, wave, G, gw, NGW; const float* const* in; };

__device__ __forceinline__ void conv_group(const Frame& F0, const Args& a, int grp, int l, int blk0) {
    if ((int)blockIdx.x < blk0) return;
    Frame F = F0; F.gw = F0.gw - blk0 * 8; F.NGW = F0.NGW - blk0 * 8; F.ws = F0.ws + ((l & 1) ? WS_WSET1 : 0);
    LAS float* scr = (LAS float*)(F.lds + F.wave * 8448); int base = 0;
    bf16_t* ws16 = (bf16_t*)F.ws;
#define WSP(off) ((bf16_t*)(F.ws + (off)))
    if (grp == 0 || grp == 2) {
        const float* wg = a.in[grp == 0 ? I_F1G : I_F2G] + (size_t)l * DM * DFF; const float* wu = a.in[grp == 0 ? I_F1U : I_F2U] + (size_t)l * DM * DFF; const float* wd = a.in[grp == 0 ? I_F1D : I_F2D] + (size_t)l * DFF * DM;
        bf16_t* gu = WSP(grp == 0 ? WS_WGU1 : WS_WGU2); bf16_t* dn = WSP(grp == 0 ? WS_WD1 : WS_WD2);
        conv_mat(wg, DM, DFF, 0, DFF, gu, 1, 0, base, F.gw, F.NGW, scr, F.lane);
        conv_mat(wu, DM, DFF, 0, DFF, gu, 1, 128, base, F.gw, F.NGW, scr, F.lane);
        conv_mat(wd, DFF, DM, 0, DM, dn, 0, 0, base, F.gw, F.NGW, scr, F.lane);
    } else if (grp == 1) {
        const float* win = a.in[I_WIN] + (size_t)l * DM * INW; const float* wgt = a.in[I_WGATE] + (size_t)l * DM * GW;
        conv_mat(win, DM, INW, 0, 3072, WSP(WS_WIG), 0, 0, base, F.gw, F.NGW, scr, F.lane);
        conv_mat(win, DM, INW, 3080, 512, WSP(WS_WIG), 0, 3072, base, F.gw, F.NGW, scr, F.lane);
        conv_mat(wgt, DM, GW, 0, GW, WSP(WS_WIG), 0, PW, base, F.gw, F.NGW, scr, F.lane);
        conv_mat(a.in[I_BRSB] + (size_t)l * 512 * DM, 512, DM, 0, DM, WSP(WS_WBR), 0, 0, base, F.gw, F.NGW, scr, F.lane);
        conv_mat(a.in[I_BRFOX] + (size_t)l * 512 * DM, 512, DM, 0, DM, WSP(WS_WBR) + (size_t)1024 * 512, 0, 0, base, F.gw, F.NGW, scr, F.lane);
        conv_mat(a.in[I_BRMEM] + (size_t)l * 512 * DM, 512, DM, 0, DM, WSP(WS_WBR) + (size_t)2 * 1024 * 512, 0, 0, base, F.gw, F.NGW, scr, F.lane);
        conv_mat(a.in[I_WOUT] + (size_t)l * DM * DM, DM, DM, 0, DM, WSP(WS_WOUT), 0, 0, base, F.gw, F.NGW, scr, F.lane);
    } else {
#pragma unroll 1
        for (int ll = 0; ll < DEPTH; ++ll) conv_mat(a.in[I_WMKV] + (size_t)ll * DM * DM, DM, DM, 0, DM, WSP(WS_WMKV) + (size_t)ll * DM * DM, 0, 0, base, F.gw, F.NGW, scr, F.lane);
    }
    (void)ws16;
#undef WSP
}

__device__ __forceinline__ void norm_rows(const Frame& F, const float* x, const float* g, bf16_t* o, int nrows) {
    f32x4 gv[4];
#pragma unroll
    for (int j = 0; j < 4; ++j) gv[j] = ((const f32x4*)g)[F.lane + 64 * j];
    for (int m = F.gw; m < nrows; m += F.NGW) {
        const f32x4* xr = (const f32x4*)(x + (size_t)m * DM) + F.lane; f32x4 v[4]; float s = 0.f;
#pragma unroll
        for (int j = 0; j < 4; ++j) { v[j] = __builtin_nontemporal_load(xr + 64 * j); s += (v[j].x * v[j].x + v[j].y * v[j].y) + (v[j].z * v[j].z + v[j].w * v[j].w); }
        const float rstd = 1.0f / sqrtf(wave_sum(s) * (1.f / DM) + RMS_EPS);
        u32x2* o8 = (u32x2*)(o + (size_t)m * DM) + F.lane;
#pragma unroll
        for (int j = 0; j < 4; ++j) { u32x2 w; w.x = cvt_pk_bf16(v[j].x * rstd * gv[j].x, v[j].y * rstd * gv[j].y); w.y = cvt_pk_bf16(v[j].z * rstd * gv[j].z, v[j].w * rstd * gv[j].w); o8[64 * j] = w; }
    }
}

__device__ __forceinline__ void ew_phase(const Frame& F, const bf16_t* f, const float* gpost, float alpha, const float* hin, float* hout, const float* gpre, bf16_t* xn,
                                         const float* win_l, const float* bfl, float* logf, int prow0) {
    LAS float* WF = (LAS float*)(F.lds + 131072 - 32768);
    if (win_l) {
        for (int e = F.tid; e < DM * 8; e += 512) WF[(e & 7) * DM + (e >> 3)] = win_l[(size_t)(e >> 3) * INW + 3072 + (e & 7)];
        asm volatile("s_waitcnt lgkmcnt(0)" ::: "memory"); __syncthreads();
    }
    f32x4 gp[4], gq[4];
#pragma unroll
    for (int j = 0; j < 4; ++j) { gp[j] = ((const f32x4*)gpost)[F.lane + 64 * j]; gq[j] = gpre ? ((const f32x4*)gpre)[F.lane + 64 * j] : (f32x4){0.f, 0.f, 0.f, 0.f}; }
    const int it_n = prow0 >= 0 ? 8 : (T + F.NGW - 1) / F.NGW;
    for (int it_ = 0; it_ < it_n; ++it_) {
        const int m = prow0 >= 0 ? prow0 + F.wave * 8 + it_ : F.gw + it_ * F.NGW; if (m >= T) break;
        const u32x2* fr = (const u32x2*)(f + (size_t)m * DM) + F.lane; const f32x4* hr = (const f32x4*)(hin + (size_t)m * DM) + F.lane;
        f32x4 fv[4], hv[4]; float s = 0.f;
#pragma unroll
        for (int j = 0; j < 4; ++j) { const u32x2 w = fr[64 * j]; hv[j] = hr[64 * j]; fv[j] = (f32x4){bf_lo(w.x), bf_hi(w.x), bf_lo(w.y), bf_hi(w.y)};
            s += (fv[j].x * fv[j].x + fv[j].y * fv[j].y) + (fv[j].z * fv[j].z + fv[j].w * fv[j].w); }
        const float rstd = alpha / sqrtf(wave_sum(s) * (1.f / DM) + RMS_EPS);
        float s2 = 0.f; f32x4* ho = (f32x4*)(hout + (size_t)m * DM) + F.lane;
#pragma unroll
        for (int j = 0; j < 4; ++j) { hv[j] = hv[j] + fv[j] * rstd * gp[j]; ho[64 * j] = hv[j]; s2 += (hv[j].x * hv[j].x + hv[j].y * hv[j].y) + (hv[j].z * hv[j].z + hv[j].w * hv[j].w); }
        if (gpre) {
            const float r2 = 1.0f / sqrtf(wave_sum(s2) * (1.f / DM) + RMS_EPS);
            u32x2* o8 = (u32x2*)(xn + (size_t)m * DM) + F.lane;
#pragma unroll
            for (int j = 0; j < 4; ++j) { hv[j] = hv[j] * r2 * gq[j]; u32x2 w; w.x = cvt_pk_bf16(hv[j].x, hv[j].y); w.y = cvt_pk_bf16(hv[j].z, hv[j].w); o8[64 * j] = w; }
            if (win_l) {
                float a8[8];
#pragma unroll
                for (int k = 0; k < 8; ++k) a8[k] = 0.f;
#pragma unroll
                for (int k = 0; k < 8; ++k)
#pragma unroll
                    for (int j = 0; j < 4; ++j) { const f32x4 w4 = *(const LAS f32x4*)(WF + k * DM + 256 * j + 4 * F.lane);
                        a8[k] += (hv[j].x * w4.x + hv[j].y * w4.y) + (hv[j].z * w4.z + hv[j].w * w4.w); }
                const bool b5 = (F.lane & 32) != 0, b4 = (F.lane & 16) != 0, b3 = (F.lane & 8) != 0;
                float r4[4], r2v[2], r1;
#pragma unroll
                for (int k = 0; k < 4; ++k) { const float keep = b5 ? a8[k + 4] : a8[k], give = b5 ? a8[k] : a8[k + 4]; r4[k] = keep + __shfl_xor(give, 32); }
#pragma unroll
                for (int k = 0; k < 2; ++k) { const float keep = b4 ? r4[k + 2] : r4[k], give = b4 ? r4[k] : r4[k + 2]; r2v[k] = keep + __shfl_xor(give, 16); }
                { const float keep = b3 ? r2v[1] : r2v[0], give = b3 ? r2v[0] : r2v[1]; r1 = keep + __shfl_xor(give, 8); }
                r1 += __shfl_xor(r1, 4); r1 += __shfl_xor(r1, 2); r1 += __shfl_xor(r1, 1);
                if ((F.lane & 7) == 0) { const int k = (b5 ? 4 : 0) + (b4 ? 2 : 0) + (b3 ? 1 : 0); const float x = r1 + bfl[k];
                    const float ls = fminf(x, 0.f) - log1pf(expf(-fabsf(x))); logf[(size_t)k * T + m] = ls * LOG2E; logf[(size_t)T * 8 + (size_t)k * T + m] = 0.f; }
            }
        }
    }
}


#define XB_TMO      128
#define XB_XCNT(j)  (256  + 64 * (j))
#define XB_XSUB(j)  (1280 + 64 * (j))
#define XB_XGEN(j)  (2304 + 64 * (j))
#define XB_TOP      3328
#define XB_TOPGEN   3392
#define XCD_BAR_WORDS 3456
#define XB_SPIN_CAP (1u << 18)
__device__ __forceinline__ unsigned xb_ld(unsigned* p)              { return __hip_atomic_load(p, __ATOMIC_RELAXED, __HIP_MEMORY_SCOPE_AGENT); }
__device__ __forceinline__ unsigned xb_add(unsigned* p, unsigned v) { return __hip_atomic_fetch_add(p, v, __ATOMIC_RELAXED, __HIP_MEMORY_SCOPE_AGENT); }
__device__ __forceinline__ unsigned xb_xcc_id() { return (unsigned)__builtin_amdgcn_s_getreg((3 << 11) | 20) & 0xFu; }
#define XB_SPIN(cond, bar) do { unsigned _sp = 0; while (cond) { __builtin_amdgcn_s_sleep(1); \
    if ((++_sp & 255u) == 0u) { if (xb_ld(&(bar)[XB_TMO])) break; if (_sp > XB_SPIN_CAP) { atomicAdd(&(bar)[XB_TMO], 1u); break; } } } } while (0)
struct XcdBarrier { unsigned* bar; unsigned x; volatile LAS unsigned* st; };
__device__ __forceinline__ XcdBarrier xcd_barrier_post(unsigned* bar, volatile LAS unsigned* st) {
    XcdBarrier b; b.bar = bar; b.x = xb_xcc_id(); b.st = st;
    if (threadIdx.x == 0) (void)xb_add(&bar[XB_XCNT(b.x)], 1u);
    return b;
}
__device__ __forceinline__ void xcd_barrier_complete(unsigned* bar, unsigned x, unsigned& nloc, unsigned& nx) {
    const unsigned G = gridDim.x * gridDim.y * gridDim.z;
    unsigned sum, cnt, mine, sp = 0u;
    for (;;) {
        sum = 0u; cnt = 0u; mine = 0u;
#pragma unroll
        for (unsigned j = 0; j < 16; ++j) { const unsigned c = xb_ld(&bar[XB_XCNT(j)]); sum += c; cnt += (c > 0u) ? 1u : 0u; mine = (j == x) ? c : mine; }
        if (sum == G) break;
        __builtin_amdgcn_s_sleep(1);
        if ((++sp & 255u) == 0u) { if (xb_ld(&bar[XB_TMO])) break; if (sp > XB_SPIN_CAP) { atomicAdd(&bar[XB_TMO], 1u); break; } }
    }
    nloc = mine > 0u ? mine : 1u; nx = cnt > 0u ? cnt : 1u;
}
__device__ __forceinline__ void xcd_barrier(const XcdBarrier& b) {
    asm volatile("s_waitcnt vmcnt(0)" ::: "memory");
    __syncthreads();
    int t_ = threadIdx.x; asm volatile("" : "+v"(t_));
    if (t_ == 0) {
        unsigned* bar = b.bar;
        __builtin_amdgcn_s_waitcnt(0);
        unsigned nloc = b.st[0], nx = b.st[1];
        if (nloc == 0u) { xcd_barrier_complete(bar, b.x, nloc, nx); b.st[0] = nloc; b.st[1] = nx; }
        const unsigned old = xb_add(&bar[XB_XSUB(b.x)], 1u);
        const unsigned gen = old / nloc;
        if (old + 1u == (gen + 1u) * nloc) {
            __builtin_amdgcn_fence(__ATOMIC_RELEASE, "agent");
            asm volatile("s_waitcnt vmcnt(0)" ::: "memory");
            const unsigned og = xb_add(&bar[XB_TOP], 1u);
            const unsigned tg = og / nx;
            if (og + 1u == (tg + 1u) * nx) xb_add(&bar[XB_TOPGEN], 1u);
            else XB_SPIN(xb_ld(&bar[XB_TOPGEN]) == tg, bar);
            __builtin_amdgcn_fence(__ATOMIC_ACQUIRE, "agent");
            xb_add(&bar[XB_XGEN(b.x)], 1u);
            asm volatile("s_waitcnt vmcnt(0)" ::: "memory");
        } else {
            XB_SPIN(xb_ld(&bar[XB_XGEN(b.x)]) == gen, bar);
            __builtin_amdgcn_fence(__ATOMIC_ACQUIRE, "agent");
            asm volatile("s_waitcnt vmcnt(0)" ::: "memory");
        }
    }
    __syncthreads();
}


__device__ __forceinline__ void panel_barrier(unsigned* pc, unsigned stage, bool wb) {
    asm volatile("s_waitcnt vmcnt(0)" ::: "memory");
    __syncthreads();
    int t_ = threadIdx.x; asm volatile("" : "+v"(t_));
    if (t_ == 0) {
        __builtin_amdgcn_s_waitcnt(0);
        if (wb) { __builtin_amdgcn_fence(__ATOMIC_RELEASE, "agent"); asm volatile("s_waitcnt vmcnt(0)" ::: "memory"); }
        xb_add(pc, 1u);
        unsigned sp = 0u; const unsigned want = 4u * stage;
        while (xb_ld(pc) < want) { __builtin_amdgcn_s_sleep(1); if (++sp > (1u << 22)) break; }
        __builtin_amdgcn_fence(__ATOMIC_ACQUIRE, "agent");
        asm volatile("s_waitcnt vmcnt(0)" ::: "memory");
    }
    __syncthreads();
}

__global__ void __launch_bounds__(512, 2) mega_fwd(Args a) {
    extern __shared__ __attribute__((aligned(16))) unsigned char lds[];
    cg::grid_group grid = cg::this_grid();
#define CG_SYNC() do { asm volatile("s_waitcnt vmcnt(0) lgkmcnt(0)" ::: "memory"); __syncthreads(); grid.sync(); \
    __builtin_amdgcn_fence(__ATOMIC_ACQUIRE, "agent"); asm volatile("s_waitcnt vmcnt(0)" ::: "memory"); } while (0)
#define GRID_SYNC() xcd_barrier(xbar)
    { volatile LAS unsigned* st_ = (volatile LAS unsigned*)((LAS unsigned char*)lds + 131072 + 64); if (threadIdx.x < 2) st_[threadIdx.x] = 0u; __syncthreads(); }
    XcdBarrier xbar = xcd_barrier_post((unsigned*)(a.ws + WS_CTL) + 4096, (volatile LAS unsigned*)((LAS unsigned char*)lds + 131072 + 64));
    Frame F;
#define MKFRAME() do { int t_ = threadIdx.x; asm volatile("" : "+v"(t_)); F.lds = (LAS unsigned char*)lds; F.ws = a.ws; F.tid = t_; F.lane = t_ & 63; F.wave = __builtin_amdgcn_readfirstlane(t_ >> 6); \
    F.G = GRIDC; F.gw = blockIdx.x * 8 + F.wave; F.NGW = F.G * 8; F.in = a.in; } while (0)
    MKFRAME();
    unsigned char* ws = a.ws;
    bf16_t* XN = (bf16_t*)(ws + WS_XN); bf16_t* FB = (bf16_t*)(ws + WS_F); bf16_t* PROJ = (bf16_t*)(ws + WS_PROJ); bf16_t* HID = PROJ; float* M32 = (float*)(ws + WS_PROJ);
    bf16_t* GB = (bf16_t*)(ws + WS_G); bf16_t* OB = (bf16_t*)(ws + WS_O); bf16_t* MEMN = (bf16_t*)(ws + WS_MEMN); bf16_t* KVMEM = (bf16_t*)(ws + WS_KVMEM); float* LOGF = (float*)(ws + WS_LOGF);
    unsigned* ctl = (unsigned*)(ws + WS_CTL);
    const int c = (int)(blockIdx.x & (GRIDC - 1));
    if (threadIdx.x == 0) __hip_atomic_store(ctl + 12288 + c, xb_xcc_id() + 1u, __ATOMIC_RELAXED, __HIP_MEMORY_SCOPE_AGENT);
#define PANEL_OF(cc) (8 * ((cc) & 7) + (((cc) >> 3) & 7))
#define PROW0() (PANEL_OF((int)blockIdx.x) * 256 + ((int)blockIdx.x >> 6) * 64)
#define PSYNC(k) do { panel_barrier((unsigned*)(a.ws + WS_CTL) + 8192 + 64 * PANEL_OF((int)blockIdx.x), 8u * (unsigned)l + (k), ((volatile LAS unsigned*)((LAS unsigned char*)lds + 131072 + 192))[0] != 0u); } while (0)

    CG_SYNC();
    conv_group(F, a, 0, 0, 0); conv_group(F, a, 1, 0, 0); conv_group(F, a, 2, 0, 0); conv_group(F, a, 3, 0, 0);
    norm_rows(F, a.in[I_MEM], a.in[I_MEMG], MEMN, NB * MEML);
    norm_rows(F, a.in[I_X], a.in[I_F1PRE], XN, T);
    GRID_SYNC();
    { const unsigned me = xb_xcc_id() + 1u; bool same = true;
#pragma unroll
        for (int q = 0; q < 4; ++q) same = same && (__hip_atomic_load(ctl + 12288 + (c & 63) + 64 * q, __ATOMIC_RELAXED, __HIP_MEMORY_SCOPE_AGENT) == me);
        if (threadIdx.x == 0) ((volatile LAS unsigned*)((LAS unsigned char*)lds + 131072 + 192))[0] = same ? 0u : 1u;
        __syncthreads(); }
#pragma unroll 1
    for (int l = 0; l < DEPTH; ++l) {
        const float* hin = (l == 0) ? a.in[I_X] : a.out;
        const unsigned char* wsl = ws + ((l & 1) ? WS_WSET1 : 0);
        { pg8::Gemm g{XN, (const bf16_t*)(wsl + WS_WGU1), DM, 0, 0}; pg8::Sched S; S.init(T, 2 * DFF, 1, false, F.G, c); pg8::EpiSwiglu E{HID};
          pg8::gemm_phase<pg8::EpiSwiglu, true>(F.lds, g, S, E); }
        if (l == 0) {
        const int kvb0 = ((T / 256) * (2 * DFF / 256)) % F.G; pg8::Gemm g{MEMN, (const bf16_t*)(ws + WS_WMKV), DM, 0, (size_t)DM * DM * 2}; pg8::Sched S; S.init(NB * MEML, DM, DEPTH, false, F.G - kvb0, c >= kvb0 ? c - kvb0 : (1 << 24));
        pg8::EpiStore E{KVMEM, DM, (size_t)DM * DM};
        pg8::gemm_phase<pg8::EpiStore, true>(F.lds, g, S, E);
    }
        if (l + 1 < DEPTH) { MKFRAME(); conv_group(F, a, 0, l + 1, ((T / 256) * (2 * DFF / 256)) % F.G + (l == 0 ? 64 : 0)); }
        PSYNC(1u);
        { pg8::Gemm g{HID, (const bf16_t*)(wsl + WS_WD1), DFF, 0, 0}; pg8::Sched S; S.init(T, DM, 1, false, F.G, c); pg8::EpiStore E{FB, DM, 0};
          pg8::gemm_phase<pg8::EpiStore, true, true>(F.lds, g, S, E); }
        PSYNC(2u);
        MKFRAME(); ew_phase(F, FB, a.in[I_F1POST] + l * DM, 0.5f, hin, a.out, a.in[I_MIXPRE] + l * DM, XN, a.in[I_WIN] + (size_t)l * DM * INW, a.in[I_BF] + l * 8, LOGF, PROW0());
        PSYNC(3u);
        { pg8::Gemm g{XN, (const bf16_t*)(wsl + WS_WIG), DM, 0, 0}; pg8::Sched S; S.init(T, PW + GW, 1, false, F.G, c); pg8::EpiIG E{PROJ, GB, a.in[I_BGATE] + l * GW, LOGF + (size_t)T * 8};
          pg8::gemm_phase<pg8::EpiIG, true>(F.lds, g, S, E); }
        if (l + 1 < DEPTH) { MKFRAME(); conv_group(F, a, 1, l + 1, ((T / 256) * ((PW + GW) / 256)) % F.G); }
        GRID_SYNC();
        {
            LAS unsigned* qw = (LAS unsigned*)(F.lds + att::L_QW); unsigned* qctr = ctl + 64 * (l + 1);
            int idx = c;
            while (idx < 1280) {
                unsigned nx;
                if (idx < 416 || idx >= 1184) {
                    const int j = idx < 416 ? idx : idx - 1184 + 416, qb = 15 - (j >> 5), bh = j & 31, b = bh >> 3, h = bh & 7; const size_t rb = (size_t)b * SEQ;
                    nx = att::attn_unit<1, 64>(PROJ + rb * PW + 1536 + h * 64, PROJ + rb * PW + 2048 + h * 64, PROJ + rb * PW + 2560 + h * 64, PW, PW, OB + (size_t)T * 512 + rb * 512 + h * 64, qb * 256, LOGF + (size_t)h * T + rb, lds, qctr);
                } else if (idx >= 672) {
                    const int j = idx - 672, qb = 15 - (j >> 5), bh = j & 31, b = bh >> 3, h = bh & 7; const size_t rb = (size_t)b * SEQ;
                    nx = att::attn_unit<0, 64>(PROJ + rb * PW + h * 64, PROJ + rb * PW + 512 + h * 64, PROJ + rb * PW + 1024 + h * 64, PW, PW, OB + rb * 512 + h * 64, qb * 256, nullptr, lds, qctr);
                } else {
                    const int j = idx - 416, qb = j & 15, bhm = j >> 4, b = bhm >> 2, hm = bhm & 3; const size_t rb = (size_t)b * SEQ;
                    const bf16_t* kv = KVMEM + (size_t)l * DM * DM + (size_t)b * MEML * DM + hm * 128;
                    nx = att::attn_unit<2, 128>(PROJ + rb * PW + 3072 + hm * 128, kv, kv + 512, PW, DM, OB + (size_t)2 * T * 512 + rb * 512 + hm * 128, qb * 256, nullptr, lds, qctr);
                }
                if (threadIdx.x == 0) qw[0] = nx + (unsigned)F.G;
                asm volatile("s_waitcnt vmcnt(0) lgkmcnt(0)" ::: "memory"); __syncthreads();
                idx = (int)qw[0];
                asm volatile("s_waitcnt lgkmcnt(0)" ::: "memory"); __syncthreads();
            }
        }
        GRID_SYNC();
        { pg8::Gemm g{OB, (const bf16_t*)(wsl + WS_WBR), 512, (size_t)T * 512 * 2, (size_t)1024 * 512 * 2}; pg8::Sched S; S.init(T, DM, 3, true, F.G, c); pg8::EpiBranch E{GB, M32, XN};
          pg8::gemm_phase<pg8::EpiBranch, true>(F.lds, g, S, E); }
        PSYNC(4u);
        { pg8::Gemm g{XN, (const bf16_t*)(wsl + WS_WOUT), DM, 0, 0}; pg8::Sched S; S.init(T, DM, 1, false, F.G, c); pg8::EpiStore E{FB, DM, 0};
          pg8::gemm_phase<pg8::EpiStore, true>(F.lds, g, S, E); }
        PSYNC(5u);
        MKFRAME(); ew_phase(F, FB, a.in[I_MIXPOST] + l * DM, 1.0f, a.out, a.out, a.in[I_F2PRE] + l * DM, XN, nullptr, nullptr, nullptr, PROW0());
        PSYNC(6u);
        { pg8::Gemm g{XN, (const bf16_t*)(wsl + WS_WGU2), DM, 0, 0}; pg8::Sched S; S.init(T, 2 * DFF, 1, false, F.G, c); pg8::EpiSwiglu E{HID};
          pg8::gemm_phase<pg8::EpiSwiglu, true>(F.lds, g, S, E); }
        if (l + 1 < DEPTH) { MKFRAME(); conv_group(F, a, 2, l + 1, ((T / 256) * (2 * DFF / 256)) % F.G); }
        PSYNC(7u);
        { pg8::Gemm g{HID, (const bf16_t*)(wsl + WS_WD2), DFF, 0, 0}; pg8::Sched S; S.init(T, DM, 1, false, F.G, c); pg8::EpiStore E{FB, DM, 0};
          pg8::gemm_phase<pg8::EpiStore, true, true>(F.lds, g, S, E); }
        PSYNC(8u);
        MKFRAME(); ew_phase(F, FB, a.in[I_F2POST] + l * DM, 0.5f, a.out, a.out, (l + 1 < DEPTH) ? a.in[I_F1PRE] + (l + 1) * DM : nullptr, XN, nullptr, nullptr, nullptr, PROW0());
        if (l + 1 < DEPTH) GRID_SYNC();
    }
}

constexpr int LDS_BYTES = 147456;
extern "C" void kernel_launch(void* const* d_in, const int* in_sizes, int n_in, void* d_out, int out_size, void* d_ws, size_t ws_size, hipStream_t stream) {
    static int grid = 0;
    if (grid == 0) {
        if (n_in != 24 || ws_size < WS_END) { fprintf(stderr, "kernel_launch: unexpected n_in %d / ws %zu\n", n_in, ws_size); grid = -1; return; }
        int dev = 0, cus = 0, per_cu = 0;
        hipGetDevice(&dev); hipDeviceGetAttribute(&cus, hipDeviceAttributeMultiprocessorCount, dev);
        if (hipFuncSetAttribute((const void*)mega_fwd, hipFuncAttributeMaxDynamicSharedMemorySize, LDS_BYTES) != hipSuccess) { fprintf(stderr, "kernel_launch: hipFuncSetAttribute failed\n"); grid = -1; return; }
        if (hipOccupancyMaxActiveBlocksPerMultiprocessor(&per_cu, (const void*)mega_fwd, 512, LDS_BYTES) != hipSuccess || per_cu < 1) { fprintf(stderr, "kernel_launch: occupancy query says %d\n", per_cu); per_cu = 1; }
        (void)hipGetLastError();
        if (cus < GRIDC) { fprintf(stderr, "kernel_launch: needs %d CUs, device has %d\n", GRIDC, cus); grid = -1; return; }
        grid = GRIDC;
    }
    if (grid < 0) return;
    hipMemsetAsync((char*)d_ws + WS_CTL, 0, 65536, stream);
    Args a{};
    for (int i = 0; i < 24; ++i) a.in[i] = (const float*)d_in[i];
    a.out = (float*)d_out; a.ws = (unsigned char*)d_ws;
    void* args[] = {&a};
    hipError_t e = hipLaunchCooperativeKernel((const void*)mega_fwd, dim3(grid), dim3(512), args, LDS_BYTES, stream);
    if (e != hipSuccess) fprintf(stderr, "cooperative launch failed: %s (grid %d)\n", hipGetErrorString(e), grid);
}
```

```cpp
#include <hip/hip_runtime.h>
#include <hip/hip_cooperative_groups.h>
#include <cstdio>
#include <cstdint>
namespace cg = cooperative_groups;

#define LAS __attribute__((address_space(3)))
typedef unsigned short bf16_t;
typedef short bf16x8 __attribute__((ext_vector_type(8)));
typedef short s16x4 __attribute__((ext_vector_type(4)));
typedef float f32x4 __attribute__((ext_vector_type(4)));
typedef float f32x2 __attribute__((ext_vector_type(2)));
typedef float f32x16 __attribute__((ext_vector_type(16)));
typedef unsigned u32x4 __attribute__((ext_vector_type(4)));
typedef unsigned u32x2 __attribute__((ext_vector_type(2)));

constexpr int GRIDC = 256;
constexpr int DM = 1024, NB = 4, SEQ = 4096, DEPTH = 4, MEML = 256, T = NB * SEQ;
constexpr int DFF = 2816, INW = 3592, PW = 3584  , GW = 3072;
constexpr float LOG2E = 1.4426950408889634f;
constexpr size_t SLOTB = (size_t)256 * PW * 2;
constexpr float RMS_EPS = 1e-6f;

constexpr size_t MiB = 1u << 20;
constexpr size_t WS_CTL = 0;
constexpr size_t WS_WGU1 = 1 * MiB;
constexpr size_t WS_WD1 = 12 * MiB;
constexpr size_t WS_WIG = 18 * MiB;
constexpr size_t WS_WBR = 31 * MiB;
constexpr size_t WS_WOUT = 34 * MiB;
constexpr size_t WS_WGU2 = 36 * MiB;
constexpr size_t WS_WD2 = 47 * MiB;
constexpr size_t WS_WMKV = 53 * MiB;
constexpr size_t WS_KVMEM = 61 * MiB;
constexpr size_t WS_MEMN = 69 * MiB;
constexpr size_t WS_LOGF = 71 * MiB;
constexpr size_t WS_KN2 = 71 * MiB + 512 * 1024;
constexpr size_t WS_XN = 72 * MiB;
constexpr size_t WS_F = 104 * MiB;
constexpr size_t WS_PROJ = 136 * MiB;
constexpr size_t WS_G = 248 * MiB;
constexpr size_t WS_O = 344 * MiB;
constexpr size_t WS_WSET1 = 391 * MiB;
constexpr size_t WS_H24 = 444 * MiB;
constexpr size_t WS_END = 492 * MiB;

typedef __bf16 bf16x2_t __attribute__((ext_vector_type(2)));
__device__ __forceinline__ unsigned cvt_pk_bf16(float lo, float hi) { f32x2 v = {lo, hi}; bf16x2_t b = __builtin_convertvector(v, bf16x2_t); return __builtin_bit_cast(unsigned, b); }
__device__ __forceinline__ float bf_lo(unsigned w) { return __uint_as_float(w << 16); }
__device__ __forceinline__ float bf_hi(unsigned w) { return __uint_as_float(w & 0xffff0000u); }
__device__ __forceinline__ float wave_sum(float v) {
#pragma unroll
    for (int o = 1; o < 64; o <<= 1) v += __shfl_xor(v, o);
    return v;
}
__device__ __forceinline__ float fast_exp2(float x) { return __builtin_amdgcn_exp2f(x); }
__device__ __forceinline__ float fast_log2(float x) { return __builtin_amdgcn_logf(x); }
__device__ __forceinline__ float fast_rcp(float x) { return __builtin_amdgcn_rcpf(x); }

namespace pg8 {
constexpr int BM = 256, BK = 64, HALF = 128, HTB = HALF * BK * 2, STAGE_BYTES = 8 * HTB, NXCD = 8, WGM = 8;
__host__ __device__ __forceinline__ int lds_byte(int r, int c) { const int st = (r >> 4) * 2 + (c >> 5), rr = r & 15, cc = c & 31, ob = rr * 64 + cc * 2; return st * 1024 + (ob ^ (((ob >> 9) & 1) << 5)); }
__host__ __device__ __forceinline__ void stage_rc(int b, int& R, int& C) { const int st = b / 1024, sb = b % 1024, swz = sb ^ (((sb >> 9) & 1) << 5); R = (st >> 1) * 16 + swz / 64; C = (st & 1) * 32 + (swz % 64) / 2; }
__host__ __device__ __forceinline__ int perm32(int rho) { const int n = rho >> 4, i = rho & 15; return 8 * (i >> 2) + 4 * n + (i & 3); }

struct Unit { int pm, pn, z; };
struct Gemm { const bf16_t* A; const bf16_t* Bt; int K; size_t zA, zB; };

struct Sched {
    int nM, nN, nZ, G, c; bool zinner;
    __device__ void init(int M, int N, int Z, bool zi, int G_, int c_) { nM = M / BM; nN = N / BM; nZ = Z; zinner = zi; G = G_; c = c_; }
    __device__ bool next(int i, Unit& u) const {
        const int nwg = nM * nN; int L, z;
        if (zinner) { z = i % nZ; L = (i / nZ) * G + c; if (L >= nwg) return false; }
        else { const long LL = (long)i * G + c; if (LL >= (long)nwg * nZ) return false; z = (int)(LL / nwg); L = (int)(LL % nwg); }
        int wgid = L; { const int q = nwg / NXCD, r = nwg % NXCD, xcd = wgid % NXCD, off = wgid / NXCD; wgid = (xcd < r ? xcd * (q + 1) : r * (q + 1) + (xcd - r) * q) + off; }
        const int nig = WGM * nN, gid = wgid / nig, fm = gid * WGM, gsz = (nM - fm) < WGM ? (nM - fm) : WGM;
        u.pm = fm + ((wgid % nig) % gsz); u.pn = (wgid % nig) / gsz; u.z = z; return true;
    }
};

#define ACC_T const f32x4 (&acc)[2][2][4][2]

struct EpiStore {
    bf16_t* O; int ldc; size_t zO;
    __device__ __forceinline__ void operator()(ACC_T, const Unit& u, int wr, int wc, int fr, int fq) const {
        const int row0 = u.pm * BM + wr * 64 + fr, col0 = u.pn * BM + wc * 32 + 8 * fq; bf16_t* base = O + (size_t)u.z * zO;
#pragma unroll
        for (int ai = 0; ai < 2; ++ai)
#pragma unroll
            for (int m = 0; m < 4; ++m) { bf16_t* rowp = base + (size_t)(row0 + ai * HALF + m * 16) * ldc + col0;
#pragma unroll
                for (int bj = 0; bj < 2; ++bj) { const f32x4 v0 = acc[ai][bj][m][0], v1 = acc[ai][bj][m][1];
                    u32x4 w; w.x = cvt_pk_bf16(v0[0], v0[1]); w.y = cvt_pk_bf16(v0[2], v0[3]); w.z = cvt_pk_bf16(v1[0], v1[1]); w.w = cvt_pk_bf16(v1[2], v1[3]);
                    *(u32x4*)(rowp + bj * HALF) = w; } }
    }
};
struct EpiSwiglu {
    bf16_t* H;
    __device__ __forceinline__ void operator()(ACC_T, const Unit& u, int wr, int wc, int fr, int fq) const {
        const int row0 = wr * 64 + fr, col0 = u.pn * HALF + wc * 32 + 8 * fq; bf16_t* Hp = H + (size_t)u.pm * (SLOTB / 2);
#pragma unroll
        for (int ai = 0; ai < 2; ++ai)
#pragma unroll
            for (int m = 0; m < 4; ++m) { bf16_t* rowp = Hp + (size_t)(row0 + ai * HALF + m * 16) * DFF + col0; float r[8];
#pragma unroll
                for (int n = 0; n < 2; ++n)
#pragma unroll
                    for (int e = 0; e < 4; ++e) { const float g = acc[ai][0][m][n][e], up = acc[ai][1][m][n][e]; r[n * 4 + e] = g * fast_rcp(1.f + fast_exp2(-g * LOG2E)) * up; }
                u32x4 w; w.x = cvt_pk_bf16(r[0], r[1]); w.y = cvt_pk_bf16(r[2], r[3]); w.z = cvt_pk_bf16(r[4], r[5]); w.w = cvt_pk_bf16(r[6], r[7]);
                *(u32x4*)rowp = w; }
    }
};
struct EpiIG {
    bf16_t* P; bf16_t* Gt; const float* bias; float* kn2;
    __device__ __forceinline__ void operator()(ACC_T, const Unit& u, int wr, int wc, int fr, int fq) const {
        const int row0 = u.pm * BM + wr * 64 + fr, cw = wc * 32 + 8 * fq;
        if (u.pn < 14) {
            float sc = 1.f; if (u.pn < 2 || u.pn == 6 || u.pn == 7) sc = 0.125f * LOG2E; else if (u.pn >= 12) sc = 0.08838834764831845f * LOG2E;
            const int col0 = u.pn * BM + cw;
#pragma unroll
            for (int ai = 0; ai < 2; ++ai)
#pragma unroll
                for (int m = 0; m < 4; ++m) { bf16_t* rowp = P + (size_t)(row0 + ai * HALF + m * 16) * PW + col0;
#pragma unroll
                    for (int bj = 0; bj < 2; ++bj) { const f32x4 v0 = acc[ai][bj][m][0] * sc, v1 = acc[ai][bj][m][1] * sc;
                        u32x4 w; w.x = cvt_pk_bf16(v0[0], v0[1]); w.y = cvt_pk_bf16(v0[2], v0[3]); w.z = cvt_pk_bf16(v1[0], v1[1]); w.w = cvt_pk_bf16(v1[2], v1[3]);
                        *(u32x4*)(rowp + bj * HALF) = w;
                        if (u.pn == 8 || u.pn == 9) {
                            float q = (v0[0] * v0[0] + v0[1] * v0[1]) + (v0[2] * v0[2] + v0[3] * v0[3]) + (v1[0] * v1[0] + v1[1] * v1[1]) + (v1[2] * v1[2] + v1[3] * v1[3]);
                            q += __shfl_xor(q, 16); q += __shfl_xor(q, 32);
                            if (fq == 0) __hip_atomic_fetch_add(kn2 + (size_t)((u.pn - 8) * 4 + bj * 2 + (wc >> 1)) * T + (row0 + ai * HALF + m * 16), q, __ATOMIC_RELAXED, __HIP_MEMORY_SCOPE_AGENT); } } }
        } else {
            const int col0 = (u.pn - 14) * BM + cw;
            f32x4 bv[2][2];
#pragma unroll
            for (int bj = 0; bj < 2; ++bj)
#pragma unroll
                for (int n = 0; n < 2; ++n) bv[bj][n] = *(const f32x4*)(bias + col0 + bj * HALF + 4 * n);
#pragma unroll
            for (int ai = 0; ai < 2; ++ai)
#pragma unroll
                for (int m = 0; m < 4; ++m) { bf16_t* rowp = Gt + (size_t)(row0 + ai * HALF + m * 16) * GW + col0;
#pragma unroll
                    for (int bj = 0; bj < 2; ++bj) { float r[8];
#pragma unroll
                        for (int n = 0; n < 2; ++n)
#pragma unroll
                            for (int e = 0; e < 4; ++e) { const float x = acc[ai][bj][m][n][e] + bv[bj][n][e]; r[n * 4 + e] = fast_rcp(1.f + fast_exp2(-x * LOG2E)); }
                        u32x4 w; w.x = cvt_pk_bf16(r[0], r[1]); w.y = cvt_pk_bf16(r[2], r[3]); w.z = cvt_pk_bf16(r[4], r[5]); w.w = cvt_pk_bf16(r[6], r[7]);
                        *(u32x4*)(rowp + bj * HALF) = w; } }
        }
    }
};
struct EpiBranch {
    const bf16_t* Gt; float* M32; bf16_t* MG;
    __device__ __forceinline__ void operator()(ACC_T, const Unit& u, int wr, int wc, int fr, int fq) const {
        const int row0 = u.pm * BM + wr * 64 + fr, col0 = u.pn * BM + wc * 32 + 8 * fq;
#pragma unroll
        for (int ai = 0; ai < 2; ++ai)
#pragma unroll
            for (int m = 0; m < 4; ++m) { const size_t row = (size_t)(row0 + ai * HALF + m * 16);
#pragma unroll
                for (int bj = 0; bj < 2; ++bj) {
                    const u32x4 gw = *(const u32x4*)(Gt + row * GW + u.z * DM + col0 + bj * HALF);
                    f32x4 v0 = acc[ai][bj][m][0], v1 = acc[ai][bj][m][1];
                    v0[0] *= bf_lo(gw.x); v0[1] *= bf_hi(gw.x); v0[2] *= bf_lo(gw.y); v0[3] *= bf_hi(gw.y);
                    v1[0] *= bf_lo(gw.z); v1[1] *= bf_hi(gw.z); v1[2] *= bf_lo(gw.w); v1[3] *= bf_hi(gw.w);
                    float* mp = M32 + (size_t)u.pm * (SLOTB / 4) + (row - (size_t)u.pm * BM) * DM + col0 + bj * HALF;
                    if (u.z > 0) { v0 += *(const f32x4*)mp; v1 += *(const f32x4*)(mp + 4); }
                    if (u.z < 2) { *(f32x4*)mp = v0; *(f32x4*)(mp + 4) = v1; }
                    else { u32x4 w; w.x = cvt_pk_bf16(v0[0], v0[1]); w.y = cvt_pk_bf16(v0[2], v0[3]); w.z = cvt_pk_bf16(v1[0], v1[1]); w.w = cvt_pk_bf16(v1[2], v1[3]);
                        *(u32x4*)(MG + row * DM + col0 + bj * HALF) = w; } } }
    }
};

template <class Epi, bool ALIGN_EPI, bool ASLOT = false>
__device__ __forceinline__ void gemm_phase(LAS unsigned char* lds, const Gemm g, const Sched& S, const Epi& E) {
    int tid_ = threadIdx.x; asm volatile("" : "+v"(tid_));
    const int tid = tid_, wid = __builtin_amdgcn_readfirstlane(tid >> 6), lane = tid & 63, wr = wid >> 2, wc = wid & 3, fr = lane & 15, fq = lane >> 4;
    const int K = g.K, nt = K / BK;
    unsigned voffA[2], voffB[2];
#pragma unroll
    for (int i = 0; i < 2; ++i) { int R, C; stage_rc(tid * 16 + i * 8192, R, C); const int Rb = (R & ~31) + perm32(R & 31);
        voffA[i] = (unsigned)(R * K + C) * 2u; voffB[i] = (unsigned)(Rb * K + C) * 2u; }
    const size_t kstep = (size_t)(BK * 2);
    const size_t hstep = (size_t)HALF * K * 2;
    const size_t tstep = 2 * hstep;
    const unsigned ldsw = (unsigned)wid * 1024u;
    const int aoff = lds_byte(wr * 64 + fr, fq * 8), boff = lds_byte(wc * 32 + fr, fq * 8);
#define PG8_SA(b, h) (((b) * 2 + (h)) * HTB)
#define PG8_SB(b, h) ((4 + (b) * 2 + (h)) * HTB)
#define PG8_STAGE(bufoff, gbase, voff) do { _Pragma("unroll") for (int _i = 0; _i < 2; ++_i) \
        __builtin_amdgcn_global_load_lds((const unsigned*)((const char*)(gbase) + (voff)[_i]), (LAS unsigned*)(lds + (bufoff) + ldsw + _i * 8192), 16, 0, 0); } while (0)
#define PG8_LDA(dst, b, h) do { _Pragma("unroll") for (int m = 0; m < 4; ++m) _Pragma("unroll") for (int k = 0; k < 2; ++k) dst[m][k] = *(const LAS bf16x8*)(lds + PG8_SA(b, h) + aoff + m * 2048 + k * 1024); } while (0)
#define PG8_LDB(dst, b, h) do { _Pragma("unroll") for (int n = 0; n < 2; ++n) _Pragma("unroll") for (int k = 0; k < 2; ++k) dst[n][k] = *(const LAS bf16x8*)(lds + PG8_SB(b, h) + boff + n * 2048 + k * 1024); } while (0)
#define PG8_MMA(ai, bj, At, Bt) do { __builtin_amdgcn_s_setprio(1); _Pragma("unroll") for (int m = 0; m < 4; ++m) _Pragma("unroll") for (int n = 0; n < 2; ++n) _Pragma("unroll") for (int k = 0; k < 2; ++k) \
        acc[ai][bj][m][n] = __builtin_amdgcn_mfma_f32_16x16x32_bf16(Bt[n][k], At[m][k], acc[ai][bj][m][n], 0, 0, 0); __builtin_amdgcn_s_setprio(0); } while (0)
#define PG8_WAIT_V(n) asm volatile("s_waitcnt vmcnt(" #n ")" ::: "memory")
#define PG8_WAIT_L(n) asm volatile("s_waitcnt lgkmcnt(" #n ")" ::: "memory")
#define PG8_BAR __builtin_amdgcn_s_barrier()
#define PG8_SCHED __builtin_amdgcn_sched_barrier(0)
    Unit cur, nxt; int ui = 0;
    if (!S.next(0, cur)) return;
    f32x4 acc[2][2][4][2];
#pragma unroll
    for (int a = 0; a < 2; ++a)
#pragma unroll
        for (int b = 0; b < 2; ++b)
#pragma unroll
            for (int m = 0; m < 4; ++m)
#pragma unroll
                for (int n = 0; n < 2; ++n) acc[a][b][m][n] = (f32x4){0.f, 0.f, 0.f, 0.f};
    bf16x8 At[4][2], B0[2][2], B1[2][2];
    const size_t pstepA = ASLOT ? SLOTB : tstep;
    const char* cA = (const char*)g.A + (size_t)cur.z * g.zA + (size_t)cur.pm * pstepA; const char* cB = (const char*)g.Bt + (size_t)cur.z * g.zB + (size_t)cur.pn * tstep;
    PG8_STAGE(PG8_SB(0, 0), cB, voffB); PG8_STAGE(PG8_SB(0, 1), cB + hstep, voffB); PG8_STAGE(PG8_SA(0, 0), cA, voffA); PG8_STAGE(PG8_SA(0, 1), cA + hstep, voffA);
    if (wr == 1) PG8_BAR;
    PG8_WAIT_V(2); PG8_BAR;
    PG8_STAGE(PG8_SB(1, 0), cB + kstep, voffB); PG8_STAGE(PG8_SA(1, 0), cA + kstep, voffA); PG8_STAGE(PG8_SB(1, 1), cB + hstep + kstep, voffB);
    PG8_WAIT_V(6); PG8_BAR;
    for (;;) {
        const bool has_next = S.next(ui + 1, nxt);
        const char* nA = has_next ? (const char*)g.A + (size_t)nxt.z * g.zA + (size_t)nxt.pm * pstepA : cA; const char* nB = has_next ? (const char*)g.Bt + (size_t)nxt.z * g.zB + (size_t)nxt.pn * tstep : cB;
        for (int t = 0; t < nt; t += 2) {
            const bool last = (t == nt - 2);
            const char* a1 = cA + (size_t)(t + 1) * kstep;
            const char* a2 = last ? nA : cA + (size_t)(t + 2) * kstep; const char* b2 = last ? nB : cB + (size_t)(t + 2) * kstep;
            const char* a3 = a2 + kstep; const char* b3 = b2 + kstep;
            PG8_LDB(B0, 0, 0); PG8_LDB(B1, 0, 1); PG8_SCHED; PG8_LDA(At, 0, 0); PG8_STAGE(PG8_SA(1, 1), a1 + hstep, voffA);
            PG8_WAIT_V(8); PG8_WAIT_L(0); PG8_BAR; PG8_MMA(0, 0, At, B0); PG8_MMA(0, 1, At, B1); PG8_BAR; PG8_SCHED;
            PG8_LDA(At, 0, 1); PG8_STAGE(PG8_SB(0, 0), b2, voffB); PG8_STAGE(PG8_SB(0, 1), b2 + hstep, voffB); PG8_STAGE(PG8_SA(0, 0), a2, voffA);
            PG8_WAIT_V(8); PG8_WAIT_L(0); PG8_BAR; PG8_MMA(1, 0, At, B0); PG8_MMA(1, 1, At, B1); PG8_BAR; PG8_SCHED;
            PG8_LDB(B0, 1, 0); PG8_LDB(B1, 1, 1); PG8_SCHED; PG8_LDA(At, 1, 0); PG8_STAGE(PG8_SA(0, 1), a2 + hstep, voffA);
            PG8_WAIT_V(8); PG8_WAIT_L(0); PG8_BAR; PG8_MMA(0, 0, At, B0); PG8_MMA(0, 1, At, B1); PG8_BAR; PG8_SCHED;
            PG8_LDA(At, 1, 1); PG8_STAGE(PG8_SB(1, 0), b3, voffB); PG8_STAGE(PG8_SB(1, 1), b3 + hstep, voffB); PG8_STAGE(PG8_SA(1, 0), a3, voffA);
            PG8_WAIT_V(8); PG8_WAIT_L(0); PG8_BAR; PG8_MMA(1, 0, At, B0); PG8_MMA(1, 1, At, B1); PG8_BAR; PG8_SCHED;
        }
        if constexpr (ALIGN_EPI) { if (wr == 0) PG8_BAR; }
        E(acc, cur, wr, wc, fr, fq);
        if (!has_next) break;
#pragma unroll
        for (int a = 0; a < 2; ++a)
#pragma unroll
            for (int b = 0; b < 2; ++b)
#pragma unroll
                for (int m = 0; m < 4; ++m)
#pragma unroll
                    for (int n = 0; n < 2; ++n) acc[a][b][m][n] = (f32x4){0.f, 0.f, 0.f, 0.f};
        cur = nxt; cA = nA; cB = nB; ++ui;
        if constexpr (ALIGN_EPI) { if (wr == 1) PG8_BAR; }
    }
    PG8_WAIT_V(0);
    if constexpr (!ALIGN_EPI) { if (wr == 0) PG8_BAR; }
    PG8_BAR;
#undef PG8_SA
#undef PG8_SB
#undef PG8_STAGE
#undef PG8_LDA
#undef PG8_LDB
#undef PG8_MMA
#undef PG8_WAIT_V
#undef PG8_WAIT_L
#undef PG8_BAR
#undef PG8_SCHED
}
}

namespace att {
constexpr int L_CS = 65536, L_FLAG = 131072, L_QW = 131072 + 128, L_WS = 131328, L_END = 133376;
constexpr float SB_THR = -152.0f;
__device__ __forceinline__ int crow(int r, int hi) { return (r & 3) + 8 * (r >> 2) + 4 * hi; }
#define SBAR() __builtin_amdgcn_sched_barrier(0)
#define WAIT_BAR0() asm volatile("s_waitcnt vmcnt(0) lgkmcnt(0)\n\ts_barrier" ::: "memory")
__device__ __forceinline__ void glds16(const void* gsrc, unsigned lds_dst) { unsigned keep;
    asm volatile("s_mov_b32 %0, m0\n\ts_mov_b32 m0, %2\n\ts_nop 0\n\tglobal_load_lds_dwordx4 %1, off\n\ts_mov_b32 m0, %0" : "=&s"(keep) : "v"(gsrc), "s"(lds_dst) : "memory"); }
__device__ __forceinline__ float swap_other(float x, int hi, float& sum) {
    auto rr = __builtin_amdgcn_permlane32_swap(__float_as_uint(x), __float_as_uint(x), false, false);
    const float a = __uint_as_float(rr[0]), b = __uint_as_float(rr[1]); sum = a + b; return hi ? a : b; }

template <int MODE, int HD>
__device__ __forceinline__ unsigned attn_unit(const bf16_t* Qb, const bf16_t* Kb, const bf16_t* Vb, int pq, int pk, bf16_t* Ob, int q0, const float* logf, unsigned char* shm, unsigned* qctr) {
    constexpr int ND = HD / 16, NO = HD / 32, NP = HD / 64, SLOT = 64 * HD * 2, L_V = 4 * SLOT;
    int tid_ = threadIdx.x; asm volatile("" : "+v"(tid_));
    const int tid = tid_, lane = tid & 63, r32 = lane & 31, hi = lane >> 5; const int wid = __builtin_amdgcn_readfirstlane(tid >> 6);
    const unsigned lds0 = (unsigned)(uintptr_t)shm;
    LAS unsigned char* shl = (LAS unsigned char*)(unsigned)(uintptr_t)shm;
    LAS float* wsf = (LAS float*)(shl + L_WS) + wid * 64;
    LAS float* CS = (LAS float*)(shl + L_CS);
    LAS unsigned* FLG = (LAS unsigned*)(shl + L_FLAG);
    const int T0 = (MODE == 2) ? 3 : (q0 + 256) / 64 - 1;
    const int tw = (MODE == 2) ? 3 : q0 / 64 + (wid >> 1);
    const int qg = q0 + 32 * wid + r32;
#define DMA_TILE(t, sl) do { _Pragma("unroll") for (int p_ = 0; p_ < NP; ++p_) { const int c_ = wid + 8 * p_; \
        glds16(Kb + (size_t)(64 * (t) + lane) * pk + c_ * 8, (unsigned)__builtin_amdgcn_readfirstlane(lds0 + (sl) * SLOT + c_ * 1024)); \
        glds16(Vb + (size_t)(64 * (t) + 16 * (c_ & 3) + (lane >> 2)) * pk + (c_ >> 2) * 32 + (lane & 3) * 8, (unsigned)__builtin_amdgcn_readfirstlane(lds0 + L_V + (sl) * SLOT + c_ * 1024)); } } while (0)
    bf16x8 qr[ND];
#pragma unroll
    for (int d0 = 0; d0 < ND; ++d0) qr[d0] = *(const bf16x8*)(Qb + (size_t)qg * pq + d0 * 16 + hi * 8);
    DMA_TILE(T0, 0); if (T0 >= 1) DMA_TILE(T0 - 1, 1); if (T0 >= 2) DMA_TILE(T0 - 2, 2);
    if (MODE == 1) {
        const int n = q0 + 256; float v[8]; float kx[8]; const float* kn = logf + (size_t)T * 8;
#pragma unroll
        for (int j = 0; j < 8; ++j) { v[j] = 0.f; kx[j] = 0.f; }
        if (8 * tid < n) {
            const f32x4 l0 = *(const f32x4*)(logf + 8 * tid), l1 = *(const f32x4*)(logf + 8 * tid + 4), k0_ = *(const f32x4*)(kn + 8 * tid), k1_ = *(const f32x4*)(kn + 8 * tid + 4);
            v[0] = l0.x; v[1] = l0.y; v[2] = l0.z; v[3] = l0.w; v[4] = l1.x; v[5] = l1.y; v[6] = l1.z; v[7] = l1.w;
            kx[0] = k0_.x; kx[1] = k0_.y; kx[2] = k0_.z; kx[3] = k0_.w; kx[4] = k1_.x; kx[5] = k1_.y; kx[6] = k1_.z; kx[7] = k1_.w; }
        float run = 0.f, mx = 0.f;
#pragma unroll
        for (int j = 0; j < 8; ++j) { run += v[j]; v[j] = run; mx = __builtin_fmaxf(mx, kx[j]); }
        float sc = run;
#pragma unroll
        for (int o = 1; o < 64; o <<= 1) { const float tt = __shfl_up(sc, o); if (lane >= o) sc += tt; }
        mx = __builtin_fmaxf(mx, __shfl_xor(mx, 1)); mx = __builtin_fmaxf(mx, __shfl_xor(mx, 2)); mx = __builtin_fmaxf(mx, __shfl_xor(mx, 4));
        LAS float* TM = CS + 4096; LAS float* PM = CS + 4096 + 64;
        if (lane == 63) wsf[0] = sc;
        if ((lane & 7) == 0) TM[tid >> 3] = mx;
        asm volatile("s_waitcnt lgkmcnt(0)\n\ts_barrier" ::: "memory");
        float base = 0.f;
#pragma unroll
        for (int w = 0; w < 8; ++w) { const float wt = ((LAS float*)(shl + L_WS))[w * 64]; if (w < wid) base += wt; }
        base += sc - run;
        if (8 * tid < n) {
#pragma unroll
            for (int j = 0; j < 8; ++j) CS[8 * tid + j] = -(base + v[j]);
        }
        if (tid < 64) {
            float pm = TM[tid];
#pragma unroll
            for (int o = 1; o < 64; o <<= 1) { const float tt = __shfl_up(pm, o); if (lane >= o) pm = __builtin_fmaxf(pm, tt); }
            PM[tid] = sqrtf(pm) * 1.01f; }
        asm volatile("s_waitcnt lgkmcnt(0)\n\ts_barrier" ::: "memory");
    }
    float qn = 0.f;
    if (MODE == 1) {
#pragma unroll
        for (int d0 = 0; d0 < ND; ++d0)
#pragma unroll
            for (int e = 0; e < 8; ++e) { const float qv = __uint_as_float(((unsigned)(unsigned short)qr[d0][e]) << 16); qn += qv * qv; }
        float qs; (void)swap_other(qn, hi, qs); qn = sqrtf(qs) * 1.01f;
    }
    float mrow = -INFINITY, lrow = 0.f, R = 0.f; bool wdone = false;
    f32x16 o[NO];
#pragma unroll
    for (int d = 0; d < NO; ++d) o[d] = f32x16{};
    const LAS unsigned char* kp0 = shl + hi * 1024 + r32 * 16;
    const int vb0 = (int)(lds0 + L_V) + ((lane >> 4) & 1) * 32 + (lane & 3) * 8 + (4 * hi + ((lane & 15) >> 2)) * 64;
    for (int it = 0; it <= T0; ++it) {
        const int t = T0 - it, sl = it & 3;
        { const int ahead = T0 - it;
          if (ahead >= 2) { if (NP == 1) asm volatile("s_waitcnt vmcnt(4) lgkmcnt(0)\n\ts_barrier" ::: "memory"); else asm volatile("s_waitcnt vmcnt(8) lgkmcnt(0)\n\ts_barrier" ::: "memory"); }
          else if (ahead == 1) { if (NP == 1) asm volatile("s_waitcnt vmcnt(2) lgkmcnt(0)\n\ts_barrier" ::: "memory"); else asm volatile("s_waitcnt vmcnt(4) lgkmcnt(0)\n\ts_barrier" ::: "memory"); }
          else WAIT_BAR0(); }
        if ((MODE == 0 || MODE == 1) && it > 0) {
            const u32x4 f0 = *(const LAS u32x4*)(FLG + ((it - 1) & 1) * 8), f1 = *(const LAS u32x4*)(FLG + ((it - 1) & 1) * 8 + 4);
            if ((f0.x & f0.y & f0.z & f0.w & f1.x & f1.y & f1.z & f1.w) != 0u) break;
        }
        if (t >= 3) DMA_TILE(t - 3, (it + 3) & 3);
        if (t <= tw && !wdone) {
            const bool diag = (t == tw) && (MODE != 2);
            f32x16 p0 = f32x16{}, p1 = f32x16{};
            if (MODE == 1) {
#pragma unroll
                for (int g = 0; g < 4; ++g) { const f32x4 c4 = *(const LAS f32x4*)(CS + 64 * t + 8 * g + 4 * hi), d4 = *(const LAS f32x4*)(CS + 64 * t + 32 + 8 * g + 4 * hi);
#pragma unroll
                    for (int j = 0; j < 4; ++j) { p0[4 * g + j] = c4[j]; p1[4 * g + j] = d4[j]; } }
            }
            { const LAS unsigned char* kb = kp0 + sl * SLOT;
#pragma unroll
              for (int d0 = 0; d0 < ND; ++d0) { const bf16x8 b0 = *(const LAS bf16x8*)(kb + d0 * 2048), b1 = *(const LAS bf16x8*)(kb + d0 * 2048 + 512);
                  p0 = __builtin_amdgcn_mfma_f32_32x32x16_bf16(b0, qr[d0], p0, 0, 0, 0); p1 = __builtin_amdgcn_mfma_f32_32x32x16_bf16(b1, qr[d0], p1, 0, 0, 0); } }
            const int kv0 = 64 * t + 4 * hi;
            const int vb = vb0 + sl * SLOT;
            s16x4 lo[NO][4], hh[NO][4];
#pragma unroll
            for (int d0 = 0; d0 < NO; ++d0)
#pragma unroll
                for (int ks = 0; ks < 4; ++ks) {
                    asm volatile("ds_read_b64_tr_b16 %0,%1 offset:%c2" : "=&v"(lo[d0][ks]) : "v"(vb), "i"(d0 * 4096 + ks * 1024) : "memory");
                    asm volatile("ds_read_b64_tr_b16 %0,%1 offset:%c2" : "=&v"(hh[d0][ks]) : "v"(vb), "i"(d0 * 4096 + ks * 1024 + 512) : "memory"); }
#define XR(i) (((i) < 16) ? p0[(i) & 15] : p1[(i) & 15])
#define XW(i, val) do { if ((i) < 16) p0[(i) & 15] = (val); else p1[(i) & 15] = (val); } while (0)
#define KVL(i) (((i) & 3) + 8 * (((i) & 15) >> 2) + 32 * ((i) >> 4))
            if (MODE == 0) {
                float ln[32];
#pragma unroll
                for (int i = 0; i < 32; ++i) { const float x = XR(i); const float e = fast_exp2(-__builtin_fabsf(x)); const float sp = __builtin_fmaxf(x, 0.f) + fast_log2(1.f + e);
                    const bool valid = !diag || (kv0 + KVL(i) < qg); ln[i] = valid ? -sp : 0.f; XW(i, valid ? x - sp : -INFINITY); }
                float tot[8];
#pragma unroll
                for (int g = 0; g < 8; ++g) { const float e0 = ln[4 * g], e1 = ln[4 * g + 1], e2 = ln[4 * g + 2], e3 = ln[4 * g + 3]; const float s2 = e3, s1 = e3 + e2, s0 = s1 + e1;
                    tot[g] = s0 + e0; ln[4 * g] = s0; ln[4 * g + 1] = s1; ln[4 * g + 2] = s2; ln[4 * g + 3] = 0.f; }
                float pt[8], pair[8];
#pragma unroll
                for (int g = 0; g < 8; ++g) pt[g] = swap_other(tot[g], hi, pair[g]);
                float ps = 0.f; float off[8];
#pragma unroll
                for (int g = 7; g >= 0; --g) { off[g] = R + ps + (hi ? 0.f : pt[g]); ps += pair[g]; }
#pragma unroll
                for (int i = 0; i < 32; ++i) XW(i, fast_exp2(XR(i) + ln[i] + off[i >> 2]));
                R += ps;
            } else {
                if (MODE == 1 && diag) {
#pragma unroll
                    for (int i = 0; i < 32; ++i) { if (kv0 + KVL(i) > qg) XW(i, -INFINITY); }
                }
                float rm = p0[0];
#pragma unroll
                for (int r = 1; r < 16; ++r) rm = __builtin_fmaxf(rm, p0[r]);
#pragma unroll
                for (int r = 0; r < 16; ++r) rm = __builtin_fmaxf(rm, p1[r]);
                { auto rr = __builtin_amdgcn_permlane32_swap(__float_as_uint(rm), __float_as_uint(rm), false, false); rm = __builtin_fmaxf(__uint_as_float(rr[0]), __uint_as_float(rr[1])); }
                const float mnew = __builtin_fmaxf(mrow, rm);
                if (__any(mnew > mrow)) {
                    const float alpha = fast_exp2(mrow - mnew); lrow *= alpha; mrow = mnew;
                    if (hi == 0) wsf[r32] = alpha;
                    asm volatile("s_waitcnt lgkmcnt(0)" ::: "memory");
#pragma unroll
                    for (int r = 0; r < 16; ++r) { const float f = wsf[crow(r, hi)];
#pragma unroll
                        for (int d = 0; d < NO; ++d) o[d][r] *= f; }
                }
                p0 = p0 - mrow; p1 = p1 - mrow;
#pragma unroll
                for (int r = 0; r < 16; ++r) { p0[r] = fast_exp2(p0[r]); p1[r] = fast_exp2(p1[r]); }
                { const f32x16 sv = p0 + p1;
                  typedef float f32x8 __attribute__((ext_vector_type(8)));
                  const f32x8 s8 = __builtin_shufflevector(sv, sv, 0, 1, 2, 3, 4, 5, 6, 7) + __builtin_shufflevector(sv, sv, 8, 9, 10, 11, 12, 13, 14, 15);
                  const f32x4 s4 = __builtin_shufflevector(s8, s8, 0, 1, 2, 3) + __builtin_shufflevector(s8, s8, 4, 5, 6, 7);
                  lrow += (s4[0] + s4[1]) + (s4[2] + s4[3]); }
            }
            u32x4 pw0, pw1, pw2, pw3;
            pw0 = (u32x4){cvt_pk_bf16(p0[0], p0[1]), cvt_pk_bf16(p0[2], p0[3]), cvt_pk_bf16(p0[4], p0[5]), cvt_pk_bf16(p0[6], p0[7])};
            pw1 = (u32x4){cvt_pk_bf16(p0[8], p0[9]), cvt_pk_bf16(p0[10], p0[11]), cvt_pk_bf16(p0[12], p0[13]), cvt_pk_bf16(p0[14], p0[15])};
            pw2 = (u32x4){cvt_pk_bf16(p1[0], p1[1]), cvt_pk_bf16(p1[2], p1[3]), cvt_pk_bf16(p1[4], p1[5]), cvt_pk_bf16(p1[6], p1[7])};
            pw3 = (u32x4){cvt_pk_bf16(p1[8], p1[9]), cvt_pk_bf16(p1[10], p1[11]), cvt_pk_bf16(p1[12], p1[13]), cvt_pk_bf16(p1[14], p1[15])};
            {
                asm volatile("s_waitcnt lgkmcnt(0)" ::: "memory"); SBAR();
#define PK(d, k) (bf16x8){lo[d][k][0], lo[d][k][1], lo[d][k][2], lo[d][k][3], hh[d][k][0], hh[d][k][1], hh[d][k][2], hh[d][k][3]}
#pragma unroll
                for (int d0 = 0; d0 < NO; ++d0) o[d0] = __builtin_amdgcn_mfma_f32_32x32x16_bf16(__builtin_bit_cast(bf16x8, pw0), PK(d0, 0), o[d0], 0, 0, 0);
#pragma unroll
                for (int d0 = 0; d0 < NO; ++d0) o[d0] = __builtin_amdgcn_mfma_f32_32x32x16_bf16(__builtin_bit_cast(bf16x8, pw1), PK(d0, 1), o[d0], 0, 0, 0);
#pragma unroll
                for (int d0 = 0; d0 < NO; ++d0) o[d0] = __builtin_amdgcn_mfma_f32_32x32x16_bf16(__builtin_bit_cast(bf16x8, pw2), PK(d0, 2), o[d0], 0, 0, 0);
#pragma unroll
                for (int d0 = 0; d0 < NO; ++d0) o[d0] = __builtin_amdgcn_mfma_f32_32x32x16_bf16(__builtin_bit_cast(bf16x8, pw3), PK(d0, 3), o[d0], 0, 0, 0);
#undef PK
            }
#undef XR
#undef XW
#undef KVL
        }
        if (MODE == 0) { const bool notdone = (t > tw) || __any(R >= SB_THR); wdone = !notdone; if (lane == 0) FLG[(it & 1) * 8 + wid] = notdone ? 0u : 1u; }
        if (MODE == 1) {
            bool notdone = true;
            if (t <= tw && t >= 1 && !wdone) { const float bound = qn * CS[4096 + 64 + (t - 1)] + CS[64 * t - 1] - mrow;     notdone = __any(!(bound < -153.0f)); }
            if (wdone) notdone = false; wdone = !notdone;
            if (lane == 0) FLG[(it & 1) * 8 + wid] = notdone ? 0u : 1u; }
    }
    WAIT_BAR0();
    unsigned nxt = 0u;
    if (tid == 0) nxt = __hip_atomic_fetch_add(qctr, 1u, __ATOMIC_RELAXED, __HIP_MEMORY_SCOPE_AGENT);
    float rinv = 1.f;
    if (MODE != 0) { float ls; (void)swap_other(lrow, hi, ls); rinv = 1.0f / ls; }
    if (hi == 0) wsf[32 + r32] = rinv;
    asm volatile("s_waitcnt lgkmcnt(0)" ::: "memory");
    float rli[16];
#pragma unroll
    for (int r = 0; r < 16; ++r) rli[r] = wsf[32 + crow(r, hi)];
    LAS bf16_t* stg = (LAS bf16_t*)(shl) + wid * 2048;
    bf16_t* Ow = Ob + (size_t)(q0 + 32 * wid) * 512;
#pragma unroll
    for (int dp = 0; dp < NP; ++dp) {
#pragma unroll
        for (int r = 0; r < 16; ++r) { const int orow = crow(r, hi);
#pragma unroll
            for (int d0 = 0; d0 < 2; ++d0) stg[orow * 64 + d0 * 32 + r32] = (bf16_t)(cvt_pk_bf16(o[2 * dp + d0][r] * rli[r], 0.f) & 0xffffu); }
        asm volatile("s_waitcnt lgkmcnt(0)" ::: "memory");
#pragma unroll
        for (int i = 0; i < 4; ++i) { const int row = i * 8 + (lane >> 3), ch = lane & 7; const u32x4 v = *(const LAS u32x4*)(stg + row * 64 + ch * 8); *(u32x4*)(Ow + (size_t)row * 512 + dp * 64 + ch * 8) = v; }
        asm volatile("s_waitcnt lgkmcnt(0)" ::: "memory");
    }
    WAIT_BAR0();
#undef DMA_TILE
    return nxt;
}
#undef SBAR
#undef WAIT_BAR0
}

struct Args { const float* in[24]; float* out; unsigned char* ws; };
enum { I_X = 0, I_MEM, I_F1PRE, I_F1POST, I_F1G, I_F1U, I_F1D, I_MIXPRE, I_MIXPOST, I_WIN, I_BF, I_MEMG, I_WMKV, I_WGATE, I_BGATE, I_BRSB, I_BRFOX, I_BRMEM, I_WOUT, I_F2PRE, I_F2POST, I_F2G, I_F2U, I_F2D };

__device__ __forceinline__ unsigned f2bf(float f) { unsigned u = __builtin_bit_cast(unsigned, f); return (u + 0x7fffu + ((u >> 16) & 1u)) >> 16; }
__device__ __forceinline__ unsigned pk2(float lo, float hi) { return f2bf(lo) | (f2bf(hi) << 16); }

__device__ __forceinline__ void tr_item(const float* W, int N, int K, int k0, int nsrc0, bf16_t* WT, int drow0, LAS float* scr, int lane) {
    float tv[32];
#pragma unroll
    for (int i = 0; i < 32; ++i) tv[i] = __builtin_nontemporal_load(&W[(size_t)(k0 + 2 * i + (lane >> 5)) * N + nsrc0 + (lane & 31)]);
#pragma unroll
    for (int i = 0; i < 32; ++i) scr[(2 * i + (lane >> 5)) * 33 + (lane & 31)] = tv[i];
    asm volatile("s_waitcnt lgkmcnt(0)" ::: "memory");
    const int c = lane & 7;
#pragma unroll
    for (int j = 0; j < 4; ++j) { const int n = (lane >> 3) + 8 * j; const LAS float* s = scr + (8 * c) * 33 + n;
        u32x4 o; o.x = pk2(s[0 * 33], s[1 * 33]); o.y = pk2(s[2 * 33], s[3 * 33]); o.z = pk2(s[4 * 33], s[5 * 33]); o.w = pk2(s[6 * 33], s[7 * 33]);
        __builtin_nontemporal_store(o, (u32x4*)(WT + (size_t)(drow0 + n) * K + k0 + 8 * c)); }
    asm volatile("s_waitcnt lgkmcnt(0)" ::: "memory");
}
__device__ __forceinline__ void conv_mat(const float* W, int K, int N, int c0, int nc, bf16_t* WT, int mode, int roff, int& base, int gw, int NGW, LAS float* scr, int lane) {
    const int nblk = nc / 32, nitems = (K / 64) * nblk;
    int first = (gw - base) % NGW; if (first < 0) first += NGW;
    for (int it = first; it < nitems; it += NGW) { const int kb = it / nblk, nb = it % nblk, n = 32 * nb;
        const int drow = mode ? ((n >> 7) * 256 + roff + (n & 127)) : (roff + n);
        tr_item(W, N, K, 64 * kb, c0 + n, WT, drow, scr, lane); }
    base += nitems;
}

struct Frame { LAS unsigned char* lds; unsigned char* ws; int tid, lane, wave, G, gw, NGW; const float* const* in; };

__device__ __forceinline__ void conv_group(const Frame& F0, const Args& a, int grp, int l, int blk0) {
    if ((int)blockIdx.x < blk0) return;
    Frame F = F0; F.gw = F0.gw - blk0 * 8; F.NGW = F0.NGW - blk0 * 8; F.ws = F0.ws + ((l & 1) ? WS_WSET1 : 0);
    LAS float* scr = (LAS float*)(F.lds + F.wave * 8448); int base = 0;
    bf16_t* ws16 = (bf16_t*)F.ws;
#define WSP(off) ((bf16_t*)(F.ws + (off)))
    if (grp == 0 || grp == 2) {
        const float* wg = a.in[grp == 0 ? I_F1G : I_F2G] + (size_t)l * DM * DFF; const float* wu = a.in[grp == 0 ? I_F1U : I_F2U] + (size_t)l * DM * DFF; const float* wd = a.in[grp == 0 ? I_F1D : I_F2D] + (size_t)l * DFF * DM;
        bf16_t* gu = WSP(grp == 0 ? WS_WGU1 : WS_WGU2); bf16_t* dn = WSP(grp == 0 ? WS_WD1 : WS_WD2);
        conv_mat(wg, DM, DFF, 0, DFF, gu, 1, 0, base, F.gw, F.NGW, scr, F.lane);
        conv_mat(wu, DM, DFF, 0, DFF, gu, 1, 128, base, F.gw, F.NGW, scr, F.lane);
        conv_mat(wd, DFF, DM, 0, DM, dn, 0, 0, base, F.gw, F.NGW, scr, F.lane);
    } else if (grp == 1) {
        const float* win = a.in[I_WIN] + (size_t)l * DM * INW; const float* wgt = a.in[I_WGATE] + (size_t)l * DM * GW;
        conv_mat(win, DM, INW, 0, 3072, WSP(WS_WIG), 0, 0, base, F.gw, F.NGW, scr, F.lane);
        conv_mat(win, DM, INW, 3080, 512, WSP(WS_WIG), 0, 3072, base, F.gw, F.NGW, scr, F.lane);
        conv_mat(wgt, DM, GW, 0, GW, WSP(WS_WIG), 0, PW, base, F.gw, F.NGW, scr, F.lane);
        conv_mat(a.in[I_BRSB] + (size_t)l * 512 * DM, 512, DM, 0, DM, WSP(WS_WBR), 0, 0, base, F.gw, F.NGW, scr, F.lane);
        conv_mat(a.in[I_BRFOX] + (size_t)l * 512 * DM, 512, DM, 0, DM, WSP(WS_WBR) + (size_t)1024 * 512, 0, 0, base, F.gw, F.NGW, scr, F.lane);
        conv_mat(a.in[I_BRMEM] + (size_t)l * 512 * DM, 512, DM, 0, DM, WSP(WS_WBR) + (size_t)2 * 1024 * 512, 0, 0, base, F.gw, F.NGW, scr, F.lane);
        conv_mat(a.in[I_WOUT] + (size_t)l * DM * DM, DM, DM, 0, DM, WSP(WS_WOUT), 0, 0, base, F.gw, F.NGW, scr, F.lane);
    } else {
#pragma unroll 1
        for (int ll = 0; ll < DEPTH; ++ll) conv_mat(a.in[I_WMKV] + (size_t)ll * DM * DM, DM, DM, 0, DM, WSP(WS_WMKV) + (size_t)ll * DM * DM, 0, 0, base, F.gw, F.NGW, scr, F.lane);
    }
    (void)ws16;
#undef WSP
}

__device__ __forceinline__ void norm_rows(const Frame& F, const float* x, const float* g, bf16_t* o, int nrows) {
    f32x4 gv[4];
#pragma unroll
    for (int j = 0; j < 4; ++j) gv[j] = ((const f32x4*)g)[F.lane + 64 * j];
    for (int m = F.gw; m < nrows; m += F.NGW) {
        const f32x4* xr = (const f32x4*)(x + (size_t)m * DM) + F.lane; f32x4 v[4]; float s = 0.f;
#pragma unroll
        for (int j = 0; j < 4; ++j) { v[j] = __builtin_nontemporal_load(xr + 64 * j); s += (v[j].x * v[j].x + v[j].y * v[j].y) + (v[j].z * v[j].z + v[j].w * v[j].w); }
        const float rstd = 1.0f / sqrtf(wave_sum(s) * (1.f / DM) + RMS_EPS);
        u32x2* o8 = (u32x2*)(o + (size_t)m * DM) + F.lane;
#pragma unroll
        for (int j = 0; j < 4; ++j) { u32x2 w; w.x = cvt_pk_bf16(v[j].x * rstd * gv[j].x, v[j].y * rstd * gv[j].y); w.y = cvt_pk_bf16(v[j].z * rstd * gv[j].z, v[j].w * rstd * gv[j].w); o8[64 * j] = w; }
    }
}


__device__ __forceinline__ unsigned r24(float f) { const unsigned u = __float_as_uint(f); return (u + 0x7fu + ((u >> 8) & 1u)) >> 8; }
__device__ __forceinline__ void store24(unsigned char* rowp, int blk, f32x4 v) { const unsigned a = r24(v.x), b = r24(v.y), c = r24(v.z), d = r24(v.w); unsigned* p = (unsigned*)(rowp + (size_t)blk * 12);
    p[0] = a | (b << 24); p[1] = (b >> 8) | (c << 16); p[2] = (c >> 16) | (d << 8); }
__device__ __forceinline__ f32x4 load24(const unsigned char* rowp, int blk) { const unsigned* p = (const unsigned*)(rowp + (size_t)blk * 12); const unsigned w0 = p[0], w1 = p[1], w2 = p[2];
    return (f32x4){__uint_as_float((w0 & 0xffffffu) << 8), __uint_as_float(((w0 >> 24) | ((w1 & 0xffffu) << 8)) << 8), __uint_as_float(((w1 >> 16) | ((w2 & 0xffu) << 16)) << 8), __uint_as_float((w2 >> 8) << 8)}; }
__device__ __forceinline__ void ew_phase(const Frame& F, const bf16_t* f, const float* gpost, float alpha, const float* hin, float* hout, const float* gpre, bf16_t* xn,
                                         const float* win_l, const float* bfl, float* logf, int prow0, unsigned char* h24, bool in24, bool out24) {
    LAS float* WF = (LAS float*)(F.lds + 131072 - 32768);
    if (win_l) {
        for (int e = F.tid; e < DM * 8; e += 512) WF[(e & 7) * DM + (e >> 3)] = win_l[(size_t)(e >> 3) * INW + 3072 + (e & 7)];
        asm volatile("s_waitcnt lgkmcnt(0)" ::: "memory"); __syncthreads();
    }
    f32x4 gp[4], gq[4];
#pragma unroll
    for (int j = 0; j < 4; ++j) { gp[j] = ((const f32x4*)gpost)[F.lane + 64 * j]; gq[j] = gpre ? ((const f32x4*)gpre)[F.lane + 64 * j] : (f32x4){0.f, 0.f, 0.f, 0.f}; }
    const int it_n = prow0 >= 0 ? 8 : (T + F.NGW - 1) / F.NGW;
    for (int it_ = 0; it_ < it_n; ++it_) {
        const int m = prow0 >= 0 ? prow0 + F.wave * 8 + it_ : F.gw + it_ * F.NGW; if (m >= T) break;
        const u32x2* fr = (const u32x2*)(f + (size_t)m * DM) + F.lane; const f32x4* hr = (const f32x4*)(hin + (size_t)m * DM) + F.lane;
        f32x4 fv[4], hv[4]; float s = 0.f;
#pragma unroll
        for (int j = 0; j < 4; ++j) { const u32x2 w = fr[64 * j]; hv[j] = in24 ? load24(h24 + (size_t)m * (DM * 3), F.lane + 64 * j) : hr[64 * j]; fv[j] = (f32x4){bf_lo(w.x), bf_hi(w.x), bf_lo(w.y), bf_hi(w.y)};
            s += (fv[j].x * fv[j].x + fv[j].y * fv[j].y) + (fv[j].z * fv[j].z + fv[j].w * fv[j].w); }
        const float rstd = alpha / sqrtf(wave_sum(s) * (1.f / DM) + RMS_EPS);
        float s2 = 0.f; f32x4* ho = (f32x4*)(hout + (size_t)m * DM) + F.lane;
#pragma unroll
        for (int j = 0; j < 4; ++j) { hv[j] = hv[j] + fv[j] * rstd * gp[j]; if (out24) store24(h24 + (size_t)m * (DM * 3), F.lane + 64 * j, hv[j]); else ho[64 * j] = hv[j]; s2 += (hv[j].x * hv[j].x + hv[j].y * hv[j].y) + (hv[j].z * hv[j].z + hv[j].w * hv[j].w); }
        if (gpre) {
            const float r2 = 1.0f / sqrtf(wave_sum(s2) * (1.f / DM) + RMS_EPS);
            u32x2* o8 = (u32x2*)(xn + (size_t)m * DM) + F.lane;
#pragma unroll
            for (int j = 0; j < 4; ++j) { hv[j] = hv[j] * r2 * gq[j]; u32x2 w; w.x = cvt_pk_bf16(hv[j].x, hv[j].y); w.y = cvt_pk_bf16(hv[j].z, hv[j].w); o8[64 * j] = w; }
            if (win_l) {
                float a8[8];
#pragma unroll
                for (int k = 0; k < 8; ++k) a8[k] = 0.f;
#pragma unroll
                for (int k = 0; k < 8; ++k)
#pragma unroll
                    for (int j = 0; j < 4; ++j) { const f32x4 w4 = *(const LAS f32x4*)(WF + k * DM + 256 * j + 4 * F.lane);
                        a8[k] += (hv[j].x * w4.x + hv[j].y * w4.y) + (hv[j].z * w4.z + hv[j].w * w4.w); }
                const bool b5 = (F.lane & 32) != 0, b4 = (F.lane & 16) != 0, b3 = (F.lane & 8) != 0;
                float r4[4], r2v[2], r1;
#pragma unroll
                for (int k = 0; k < 4; ++k) { const float keep = b5 ? a8[k + 4] : a8[k], give = b5 ? a8[k] : a8[k + 4]; r4[k] = keep + __shfl_xor(give, 32); }
#pragma unroll
                for (int k = 0; k < 2; ++k) { const float keep = b4 ? r4[k + 2] : r4[k], give = b4 ? r4[k] : r4[k + 2]; r2v[k] = keep + __shfl_xor(give, 16); }
                { const float keep = b3 ? r2v[1] : r2v[0], give = b3 ? r2v[0] : r2v[1]; r1 = keep + __shfl_xor(give, 8); }
                r1 += __shfl_xor(r1, 4); r1 += __shfl_xor(r1, 2); r1 += __shfl_xor(r1, 1);
                if ((F.lane & 7) == 0) { const int k = (b5 ? 4 : 0) + (b4 ? 2 : 0) + (b3 ? 1 : 0); const float x = r1 + bfl[k];
                    const float ls = fminf(x, 0.f) - log1pf(expf(-fabsf(x))); logf[(size_t)k * T + m] = ls * LOG2E; logf[(size_t)T * 8 + (size_t)k * T + m] = 0.f; }
            }
        }
    }
}


#define XB_TMO      128
#define XB_XCNT(j)  (256  + 64 * (j))
#define XB_XSUB(j)  (1280 + 64 * (j))
#define XB_XGEN(j)  (2304 + 64 * (j))
#define XB_TOP      3328
#define XB_TOPGEN   3392
#define XCD_BAR_WORDS 3456
#define XB_SPIN_CAP (1u << 18)
__device__ __forceinline__ unsigned xb_ld(unsigned* p)              { return __hip_atomic_load(p, __ATOMIC_RELAXED, __HIP_MEMORY_SCOPE_AGENT); }
__device__ __forceinline__ unsigned xb_add(unsigned* p, unsigned v) { return __hip_atomic_fetch_add(p, v, __ATOMIC_RELAXED, __HIP_MEMORY_SCOPE_AGENT); }
__device__ __forceinline__ unsigned xb_xcc_id() { return (unsigned)__builtin_amdgcn_s_getreg((3 << 11) | 20) & 0xFu; }
#define XB_SPIN(cond, bar) do { unsigned _sp = 0; while (cond) { __builtin_amdgcn_s_sleep(1); \
    if ((++_sp & 255u) == 0u) { if (xb_ld(&(bar)[XB_TMO])) break; if (_sp > XB_SPIN_CAP) { atomicAdd(&(bar)[XB_TMO], 1u); break; } } } } while (0)
struct XcdBarrier { unsigned* bar; unsigned x; volatile LAS unsigned* st; };
__device__ __forceinline__ XcdBarrier xcd_barrier_post(unsigned* bar, volatile LAS unsigned* st) {
    XcdBarrier b; b.bar = bar; b.x = xb_xcc_id(); b.st = st;
    if (threadIdx.x == 0) (void)xb_add(&bar[XB_XCNT(b.x)], 1u);
    return b;
}
__device__ __forceinline__ void xcd_barrier_complete(unsigned* bar, unsigned x, unsigned& nloc, unsigned& nx) {
    const unsigned G = gridDim.x * gridDim.y * gridDim.z;
    unsigned sum, cnt, mine, sp = 0u;
    for (;;) {
        sum = 0u; cnt = 0u; mine = 0u;
#pragma unroll
        for (unsigned j = 0; j < 16; ++j) { const unsigned c = xb_ld(&bar[XB_XCNT(j)]); sum += c; cnt += (c > 0u) ? 1u : 0u; mine = (j == x) ? c : mine; }
        if (sum == G) break;
        __builtin_amdgcn_s_sleep(1);
        if ((++sp & 255u) == 0u) { if (xb_ld(&bar[XB_TMO])) break; if (sp > XB_SPIN_CAP) { atomicAdd(&bar[XB_TMO], 1u); break; } }
    }
    nloc = mine > 0u ? mine : 1u; nx = cnt > 0u ? cnt : 1u;
}
__device__ __forceinline__ void xcd_barrier(const XcdBarrier& b) {
    asm volatile("s_waitcnt vmcnt(0)" ::: "memory");
    __syncthreads();
    int t_ = threadIdx.x; asm volatile("" : "+v"(t_));
    if (t_ == 0) {
        unsigned* bar = b.bar;
        __builtin_amdgcn_s_waitcnt(0);
        unsigned nloc = b.st[0], nx = b.st[1];
        if (nloc == 0u) { xcd_barrier_complete(bar, b.x, nloc, nx); b.st[0] = nloc; b.st[1] = nx; }
        const unsigned old = xb_add(&bar[XB_XSUB(b.x)], 1u);
        const unsigned gen = old / nloc;
        if (old + 1u == (gen + 1u) * nloc) {
            __builtin_amdgcn_fence(__ATOMIC_RELEASE, "agent");
            asm volatile("s_waitcnt vmcnt(0)" ::: "memory");
            const unsigned og = xb_add(&bar[XB_TOP], 1u);
            const unsigned tg = og / nx;
            if (og + 1u == (tg + 1u) * nx) xb_add(&bar[XB_TOPGEN], 1u);
            else XB_SPIN(xb_ld(&bar[XB_TOPGEN]) == tg, bar);
            __builtin_amdgcn_fence(__ATOMIC_ACQUIRE, "agent");
            xb_add(&bar[XB_XGEN(b.x)], 1u);
            asm volatile("s_waitcnt vmcnt(0)" ::: "memory");
        } else {
            XB_SPIN(xb_ld(&bar[XB_XGEN(b.x)]) == gen, bar);
            __builtin_amdgcn_fence(__ATOMIC_ACQUIRE, "agent");
            asm volatile("s_waitcnt vmcnt(0)" ::: "memory");
        }
    }
    __syncthreads();
}


__device__ __forceinline__ void panel_barrier(unsigned* pc, unsigned stage, bool wb) {
    asm volatile("s_waitcnt vmcnt(0)" ::: "memory");
    __syncthreads();
    int t_ = threadIdx.x; asm volatile("" : "+v"(t_));
    if (t_ == 0) {
        __builtin_amdgcn_s_waitcnt(0);
        if (wb) { __builtin_amdgcn_fence(__ATOMIC_RELEASE, "agent"); asm volatile("s_waitcnt vmcnt(0)" ::: "memory"); }
        xb_add(pc, 1u);
        unsigned sp = 0u; const unsigned want = 4u * stage;
        while (xb_ld(pc) < want) { __builtin_amdgcn_s_sleep(1); if (++sp > (1u << 22)) break; }
        __builtin_amdgcn_fence(__ATOMIC_ACQUIRE, "agent");
        asm volatile("s_waitcnt vmcnt(0)" ::: "memory");
    }
    __syncthreads();
}

__global__ void __launch_bounds__(512, 2) mega_fwd(Args a) {
    extern __shared__ __attribute__((aligned(16))) unsigned char lds[];
    cg::grid_group grid = cg::this_grid();
#define CG_SYNC() do { asm volatile("s_waitcnt vmcnt(0) lgkmcnt(0)" ::: "memory"); __syncthreads(); grid.sync(); \
    __builtin_amdgcn_fence(__ATOMIC_ACQUIRE, "agent"); asm volatile("s_waitcnt vmcnt(0)" ::: "memory"); } while (0)
#define GRID_SYNC() xcd_barrier(xbar)
    { volatile LAS unsigned* st_ = (volatile LAS unsigned*)((LAS unsigned char*)lds + 131072 + 64); if (threadIdx.x < 2) st_[threadIdx.x] = 0u; __syncthreads(); }
    XcdBarrier xbar = xcd_barrier_post((unsigned*)(a.ws + WS_CTL) + 4096, (volatile LAS unsigned*)((LAS unsigned char*)lds + 131072 + 64));
    Frame F;
#define MKFRAME() do { int t_ = threadIdx.x; asm volatile("" : "+v"(t_)); F.lds = (LAS unsigned char*)lds; F.ws = a.ws; F.tid = t_; F.lane = t_ & 63; F.wave = __builtin_amdgcn_readfirstlane(t_ >> 6); \
    F.G = GRIDC; F.gw = blockIdx.x * 8 + F.wave; F.NGW = F.G * 8; F.in = a.in; } while (0)
    MKFRAME();
    unsigned char* ws = a.ws;
    bf16_t* XN = (bf16_t*)(ws + WS_XN); bf16_t* FB = (bf16_t*)(ws + WS_F); bf16_t* PROJ = (bf16_t*)(ws + WS_PROJ); bf16_t* HID = PROJ; float* M32 = (float*)(ws + WS_PROJ);
    bf16_t* GB = (bf16_t*)(ws + WS_G); bf16_t* OB = (bf16_t*)(ws + WS_O); bf16_t* MEMN = (bf16_t*)(ws + WS_MEMN); bf16_t* KVMEM = (bf16_t*)(ws + WS_KVMEM); float* LOGF = (float*)(ws + WS_LOGF);
    unsigned* ctl = (unsigned*)(ws + WS_CTL);
    const int c = (int)(blockIdx.x & (GRIDC - 1));
    if (threadIdx.x == 0) __hip_atomic_store(ctl + 12288 + c, xb_xcc_id() + 1u, __ATOMIC_RELAXED, __HIP_MEMORY_SCOPE_AGENT);
#define PANEL_OF(cc) (8 * ((cc) & 7) + (((cc) >> 3) & 7))
#define PROW0() (PANEL_OF((int)blockIdx.x) * 256 + ((int)blockIdx.x >> 6) * 64)
#define PSYNC(k) do { panel_barrier((unsigned*)(a.ws + WS_CTL) + 8192 + 64 * PANEL_OF((int)blockIdx.x), 8u * (unsigned)l + (k), ((volatile LAS unsigned*)((LAS unsigned char*)lds + 131072 + 192))[0] != 0u); } while (0)

    CG_SYNC();
    conv_group(F, a, 0, 0, 0); conv_group(F, a, 1, 0, 0); conv_group(F, a, 2, 0, 0); conv_group(F, a, 3, 0, 0);
    norm_rows(F, a.in[I_MEM], a.in[I_MEMG], MEMN, NB * MEML);
    norm_rows(F, a.in[I_X], a.in[I_F1PRE], XN, T);
    GRID_SYNC();
    { const unsigned me = xb_xcc_id() + 1u; bool same = true;
#pragma unroll
        for (int q = 0; q < 4; ++q) same = same && (__hip_atomic_load(ctl + 12288 + (c & 63) + 64 * q, __ATOMIC_RELAXED, __HIP_MEMORY_SCOPE_AGENT) == me);
        if (threadIdx.x == 0) ((volatile LAS unsigned*)((LAS unsigned char*)lds + 131072 + 192))[0] = same ? 0u : 1u;
        __syncthreads(); }
#pragma unroll 1
    for (int l = 0; l < DEPTH; ++l) {
        const float* hin = (l == 0) ? a.in[I_X] : a.out;
        const unsigned char* wsl = ws + ((l & 1) ? WS_WSET1 : 0);
        { pg8::Gemm g{XN, (const bf16_t*)(wsl + WS_WGU1), DM, 0, 0}; pg8::Sched S; S.init(T, 2 * DFF, 1, false, F.G, c); pg8::EpiSwiglu E{HID};
          pg8::gemm_phase<pg8::EpiSwiglu, true>(F.lds, g, S, E); }
        if (l == 0) {
        const int kvb0 = ((T / 256) * (2 * DFF / 256)) % F.G; pg8::Gemm g{MEMN, (const bf16_t*)(ws + WS_WMKV), DM, 0, (size_t)DM * DM * 2}; pg8::Sched S; S.init(NB * MEML, DM, DEPTH, false, F.G - kvb0, c >= kvb0 ? c - kvb0 : (1 << 24));
        pg8::EpiStore E{KVMEM, DM, (size_t)DM * DM};
        pg8::gemm_phase<pg8::EpiStore, true>(F.lds, g, S, E);
    }
        if (l + 1 < DEPTH) { MKFRAME(); conv_group(F, a, 0, l + 1, ((T / 256) * (2 * DFF / 256)) % F.G + (l == 0 ? 64 : 0)); }
        PSYNC(1u);
        { pg8::Gemm g{HID, (const bf16_t*)(wsl + WS_WD1), DFF, 0, 0}; pg8::Sched S; S.init(T, DM, 1, false, F.G, c); pg8::EpiStore E{FB, DM, 0};
          pg8::gemm_phase<pg8::EpiStore, true, true>(F.lds, g, S, E); }
        PSYNC(2u);
        MKFRAME(); ew_phase(F, FB, a.in[I_F1POST] + l * DM, 0.5f, hin, a.out, a.in[I_MIXPRE] + l * DM, XN, a.in[I_WIN] + (size_t)l * DM * INW, a.in[I_BF] + l * 8, LOGF, PROW0(), ws + WS_H24, l != 0, true);
        PSYNC(3u);
        { pg8::Gemm g{XN, (const bf16_t*)(wsl + WS_WIG), DM, 0, 0}; pg8::Sched S; S.init(T, PW + GW, 1, false, F.G, c); pg8::EpiIG E{PROJ, GB, a.in[I_BGATE] + l * GW, LOGF + (size_t)T * 8};
          pg8::gemm_phase<pg8::EpiIG, true>(F.lds, g, S, E); }
        if (l + 1 < DEPTH) { MKFRAME(); conv_group(F, a, 1, l + 1, ((T / 256) * ((PW + GW) / 256)) % F.G); }
        GRID_SYNC();
        {
            LAS unsigned* qw = (LAS unsigned*)(F.lds + att::L_QW); unsigned* qctr = ctl + 64 * (l + 1);
            int idx = c;
            while (idx < 1280) {
                unsigned nx;
                if (idx < 416 || idx >= 1184) {
                    const int j = idx < 416 ? idx : idx - 1184 + 416, qb = 15 - (j >> 5), bh = j & 31, b = bh >> 3, h = bh & 7; const size_t rb = (size_t)b * SEQ;
                    nx = att::attn_unit<1, 64>(PROJ + rb * PW + 1536 + h * 64, PROJ + rb * PW + 2048 + h * 64, PROJ + rb * PW + 2560 + h * 64, PW, PW, OB + (size_t)T * 512 + rb * 512 + h * 64, qb * 256, LOGF + (size_t)h * T + rb, lds, qctr);
                } else if (idx >= 672) {
                    const int j = idx - 672, qb = 15 - (j >> 5), bh = j & 31, b = bh >> 3, h = bh & 7; const size_t rb = (size_t)b * SEQ;
                    nx = att::attn_unit<0, 64>(PROJ + rb * PW + h * 64, PROJ + rb * PW + 512 + h * 64, PROJ + rb * PW + 1024 + h * 64, PW, PW, OB + rb * 512 + h * 64, qb * 256, nullptr, lds, qctr);
                } else {
                    const int j = idx - 416, qb = j & 15, bhm = j >> 4, b = bhm >> 2, hm = bhm & 3; const size_t rb = (size_t)b * SEQ;
                    const bf16_t* kv = KVMEM + (size_t)l * DM * DM + (size_t)b * MEML * DM + hm * 128;
                    nx = att::attn_unit<2, 128>(PROJ + rb * PW + 3072 + hm * 128, kv, kv + 512, PW, DM, OB + (size_t)2 * T * 512 + rb * 512 + hm * 128, qb * 256, nullptr, lds, qctr);
                }
                if (threadIdx.x == 0) qw[0] = nx + (unsigned)F.G;
                asm volatile("s_waitcnt vmcnt(0) lgkmcnt(0)" ::: "memory"); __syncthreads();
                idx = (int)qw[0];
                asm volatile("s_waitcnt lgkmcnt(0)" ::: "memory"); __syncthreads();
            }
        }
        GRID_SYNC();
        { pg8::Gemm g{OB, (const bf16_t*)(wsl + WS_WBR), 512, (size_t)T * 512 * 2, (size_t)1024 * 512 * 2}; pg8::Sched S; S.init(T, DM, 3, true, F.G, c); pg8::EpiBranch E{GB, M32, XN};
          pg8::gemm_phase<pg8::EpiBranch, true>(F.lds, g, S, E); }
        PSYNC(4u);
        { pg8::Gemm g{XN, (const bf16_t*)(wsl + WS_WOUT), DM, 0, 0}; pg8::Sched S; S.init(T, DM, 1, false, F.G, c); pg8::EpiStore E{FB, DM, 0};
          pg8::gemm_phase<pg8::EpiStore, true>(F.lds, g, S, E); }
        PSYNC(5u);
        MKFRAME(); ew_phase(F, FB, a.in[I_MIXPOST] + l * DM, 1.0f, a.out, a.out, a.in[I_F2PRE] + l * DM, XN, nullptr, nullptr, nullptr, PROW0(), ws + WS_H24, true, true);
        PSYNC(6u);
        { pg8::Gemm g{XN, (const bf16_t*)(wsl + WS_WGU2), DM, 0, 0}; pg8::Sched S; S.init(T, 2 * DFF, 1, false, F.G, c); pg8::EpiSwiglu E{HID};
          pg8::gemm_phase<pg8::EpiSwiglu, true>(F.lds, g, S, E); }
        if (l + 1 < DEPTH) { MKFRAME(); conv_group(F, a, 2, l + 1, ((T / 256) * (2 * DFF / 256)) % F.G); }
        PSYNC(7u);
        { pg8::Gemm g{HID, (const bf16_t*)(wsl + WS_WD2), DFF, 0, 0}; pg8::Sched S; S.init(T, DM, 1, false, F.G, c); pg8::EpiStore E{FB, DM, 0};
          pg8::gemm_phase<pg8::EpiStore, true, true>(F.lds, g, S, E); }
        PSYNC(8u);
        MKFRAME(); ew_phase(F, FB, a.in[I_F2POST] + l * DM, 0.5f, a.out, a.out, (l + 1 < DEPTH) ? a.in[I_F1PRE] + (l + 1) * DM : nullptr, XN, nullptr, nullptr, nullptr, PROW0(), ws + WS_H24, true, l + 1 < DEPTH);
        if (l + 1 < DEPTH) GRID_SYNC();
    }
}

constexpr int LDS_BYTES = 147456;
extern "C" void kernel_launch(void* const* d_in, const int* in_sizes, int n_in, void* d_out, int out_size, void* d_ws, size_t ws_size, hipStream_t stream) {
    static int grid = 0;
    if (grid == 0) {
        if (n_in != 24 || ws_size < WS_END) { fprintf(stderr, "kernel_launch: unexpected n_in %d / ws %zu\n", n_in, ws_size); grid = -1; return; }
        int dev = 0, cus = 0, per_cu = 0;
        hipGetDevice(&dev); hipDeviceGetAttribute(&cus, hipDeviceAttributeMultiprocessorCount, dev);
        if (hipFuncSetAttribute((const void*)mega_fwd, hipFuncAttributeMaxDynamicSharedMemorySize, LDS_BYTES) != hipSuccess) { fprintf(stderr, "kernel_launch: hipFuncSetAttribute failed\n"); grid = -1; return; }
        if (hipOccupancyMaxActiveBlocksPerMultiprocessor(&per_cu, (const void*)mega_fwd, 512, LDS_BYTES) != hipSuccess || per_cu < 1) { fprintf(stderr, "kernel_launch: occupancy query says %d\n", per_cu); per_cu = 1; }
        (void)hipGetLastError();
        if (cus < GRIDC) { fprintf(stderr, "kernel_launch: needs %d CUs, device has %d\n", GRIDC, cus); grid = -1; return; }
        grid = GRIDC;
    }
    if (grid < 0) return;
    hipMemsetAsync((char*)d_ws + WS_CTL, 0, 65536, stream);
    Args a{};
    for (int i = 0; i < 24; ++i) a.in[i] = (const float*)d_in[i];
    a.out = (float*)d_out; a.ws = (unsigned char*)d_ws;
    void* args[] = {&a};
    hipError_t e = hipLaunchCooperativeKernel((const void*)mega_fwd, dim3(grid), dim3(512), args, LDS_BYTES, stream);
    if (e != hipSuccess) fprintf(stderr, "cooperative launch failed: %s (grid %d)\n", hipGetErrorString(e), grid);
}
```
